# Optimizing an MI355X kernel written in HIP

```python
import math
import jax
import jax.numpy as jnp
from jax import lax
import numpy as np

D_MODEL = 2048
BATCH = 8
SEQ = 2048
DEPTH = 2

GRID_W = 64
CTX_LEN = 256
N_EVEN = (DEPTH + 1) // 2
N_ODD = DEPTH // 2

DIFF_QK_DIM = 64
DIFF_V_DIM = 2 * DIFF_QK_DIM
FOURIER_WIDTH = D_MODEL // 4
FOURIER_GROUP_DIM = 128
FOURIER_GROUPS = FOURIER_WIDTH // FOURIER_GROUP_DIM
DIFF_WIDTH = D_MODEL - FOURIER_WIDTH
DIFF_HEADS = DIFF_WIDTH // DIFF_V_DIM
EVEN_IN_WIDTH = 3 * DIFF_WIDTH + FOURIER_WIDTH
ROPE_AXIS_DIM = DIFF_QK_DIM // 2
ROPE_BASE = 10000.0
Q_BLOCK = 128

HGRN_EXPAND = 128
HGRN_HEADS = D_MODEL // HGRN_EXPAND
HGRN_HEAD_V = D_MODEL // HGRN_HEADS
FORGET_DIM = HGRN_HEADS * HGRN_EXPAND
HGRN_IN_WIDTH = 3 * FORGET_DIM + 2 * D_MODEL
HGRN_CHUNK = 32

D_FF = 5504
CONV_W = 3

ALPHA = (2.0 * DEPTH) ** 0.25
BETA = (8.0 * DEPTH) ** -0.25
LN_EPS = 1e-6
RMS_EPS = 1e-5
MOD_INIT = 0.5

kernel_name = 'hybrid_diffattn_fnet_hgrn2_dit'


def layer_norm(t, g=None, b=None):
    t32 = t.astype(jnp.float32)
    mu = jnp.mean(t32, axis=-1, keepdims=True)
    var = jnp.mean(jnp.square(t32 - mu), axis=-1, keepdims=True)
    y = (t32 - mu) * lax.rsqrt(var + LN_EPS)
    if g is not None:
        y = y * g.astype(jnp.float32) + b.astype(jnp.float32)
    return y.astype(t.dtype)


def rms_norm(t, w):
    t32 = t.astype(jnp.float32)
    y = t32 * lax.rsqrt(jnp.mean(jnp.square(t32), axis=-1, keepdims=True) + RMS_EPS) * w.astype(jnp.float32)
    return y.astype(t.dtype)


def modulate(t, shift, scale):
    return t * (1 + scale) + shift


def residual_post_norm(h, update, g, b):
    return layer_norm(ALPHA * h + update, g, b)


def to_heads(t, hd):
    b, n, _ = t.shape
    return t.reshape(b, n, -1, hd).transpose(0, 2, 1, 3)


def from_heads(t):
    b, h, n, d = t.shape
    return t.transpose(0, 2, 1, 3).reshape(b, n, h * d)


def rope_tables(ids):
    inv = 1.0 / (ROPE_BASE ** (jnp.arange(0, ROPE_AXIS_DIM, 2, dtype=jnp.float32) / ROPE_AXIS_DIM))
    ang = ids.astype(jnp.float32)[:, None] * inv[None, :]
    return jnp.cos(ang), jnp.sin(ang)


def rotate(t, cos, sin):
    half = t.shape[-1] // 2
    t1, t2 = t[..., :half], t[..., half:]
    cos = cos.astype(t.dtype)
    sin = sin.astype(t.dtype)
    return jnp.concatenate([t1 * cos - t2 * sin, t2 * cos + t1 * sin], axis=-1)


def axial_rope(t, rope):
    cos_r, sin_r, cos_c, sin_c = rope
    return jnp.concatenate([rotate(t[..., :ROPE_AXIS_DIM], cos_r, sin_r),
                            rotate(t[..., ROPE_AXIS_DIM:], cos_c, sin_c)], axis=-1)


def diff_attend(q1, q2, k1, k2, v, lam):
    scale = DIFF_QK_DIM ** -0.5
    s1 = jnp.einsum('bhqd,bhkd->bhqk', q1, k1).astype(jnp.float32) * scale
    s2 = jnp.einsum('bhqd,bhkd->bhqk', q2, k2).astype(jnp.float32) * scale
    p = jax.nn.softmax(s1, axis=-1) - lam * jax.nn.softmax(s2, axis=-1)
    return jnp.einsum('bhqk,bhkd->bhqd', p.astype(v.dtype), v)


def diff_attend_blocked(q1, q2, k1, k2, v, lam):
    b, h, n, d = q1.shape
    nb = n // Q_BLOCK
    blocks = lambda t: t.reshape(b, h, nb, Q_BLOCK, d).transpose(2, 0, 1, 3, 4)
    out = lax.map(lambda qs: diff_attend(qs[0], qs[1], k1, k2, v, lam), (blocks(q1), blocks(q2)))
    return out.transpose(1, 2, 0, 3, 4).reshape(b, h, n, v.shape[-1])


def fourier_mix(u):
    b, n, _ = u.shape
    g = u.reshape(b, n, FOURIER_GROUPS, FOURIER_GROUP_DIM).astype(jnp.float32)
    y = jnp.fft.fft2(g, axes=(1, 3), norm='ortho').real
    return y.reshape(b, n, FOURIER_WIDTH).astype(u.dtype)


def even_mixer(u_lat, u_ctx, rope, w_in, w_out, lam_vecs, subln_w, lam_init, need_ctx):
    splits = [DIFF_WIDTH, 2 * DIFF_WIDTH, 3 * DIFF_WIDTH]
    q_l, k_l, v_l, f_l = jnp.split(u_lat @ w_in, splits, axis=-1)
    q_c, k_c, v_c, f_c = jnp.split(u_ctx @ w_in, splits, axis=-1)
    lv = lam_vecs.astype(jnp.float32)
    lam = jnp.exp(jnp.sum(lv[0] * lv[1])) - jnp.exp(jnp.sum(lv[2] * lv[3])) + lam_init

    def pair(t, use_rope):
        th = to_heads(t, DIFF_V_DIM)
        a, b = th[..., :DIFF_QK_DIM], th[..., DIFF_QK_DIM:]
        if use_rope:
            a, b = axial_rope(a, rope), axial_rope(b, rope)
        return a, b

    q1, q2 = pair(q_l, True)
    k1, k2 = pair(k_l, True)
    kc1, kc2 = pair(k_c, False)
    v = to_heads(v_l, DIFF_V_DIM)
    vc = to_heads(v_c, DIFF_V_DIM)

    def merge(attn, four_in):
        attn = rms_norm(attn, subln_w) * (1.0 - lam_init)
        return jnp.concatenate([from_heads(attn), fourier_mix(four_in)], axis=-1) @ w_out

    keys1 = jnp.concatenate([kc1, k1], axis=2)
    keys2 = jnp.concatenate([kc2, k2], axis=2)
    vals = jnp.concatenate([vc, v], axis=2)
    m_lat = merge(diff_attend_blocked(q1, q2, keys1, keys2, vals, lam), f_l)
    m_ctx = None
    if need_ctx:
        qc1, qc2 = pair(q_c, False)
        m_ctx = merge(diff_attend(qc1, qc2, kc1, kc2, vc, lam), f_c)
    return m_lat, m_ctx


def gla_chunked(q, k, v, logf, state):
    b, n, h, dk = q.shape
    dv = v.shape[-1]
    nc = n // HGRN_CHUNK
    to_chunks = lambda t: t.reshape(b, nc, HGRN_CHUNK, h, t.shape[-1]).transpose(1, 0, 3, 2, 4)
    mask = jnp.tril(jnp.ones((HGRN_CHUNK, HGRN_CHUNK), dtype=bool))

    def step(s, inp):
        qc, kc, vc, gc = inp
        cum = jnp.cumsum(gc, axis=2)
        o_inter = jnp.einsum('bhtk,bhkv->bhtv', qc * jnp.exp(cum), s)
        rel = cum[:, :, :, None, :] - cum[:, :, None, :, :]
        decay = jnp.exp(jnp.where(mask[:, :, None], rel, -jnp.inf))
        scores = jnp.einsum('bhtk,bhsk,bhtsk->bhts', qc, kc, decay)
        o_intra = jnp.einsum('bhts,bhsv->bhtv', scores, vc)
        cum_end = cum[:, :, -1:, :]
        s = jnp.exp(cum_end[:, :, 0, :])[..., None] * s + jnp.einsum('bhsk,bhsv->bhkv', kc * jnp.exp(cum_end - cum), vc)
        return s, o_inter + o_intra

    s_final, o = lax.scan(step, state, (to_chunks(q), to_chunks(k), to_chunks(v), to_chunks(logf)))
    return o.transpose(1, 0, 3, 2, 4).reshape(b, n, h, dv), s_final


def hgrn_mixer(u_lat, u_ctx, w_in, w_out, lb, norm_w, need_ctx):
    splits = [FORGET_DIM, 2 * FORGET_DIM, 3 * FORGET_DIM, 3 * FORGET_DIM + D_MODEL]

    def prep(u):
        b, n, _ = u.shape
        q, f_fwd, f_bwd, i, g = jnp.split(u @ w_in, splits, axis=-1)
        hd = lambda t, d: t.reshape(b, n, HGRN_HEADS, d).astype(jnp.float32)
        q = jax.nn.silu(hd(q, HGRN_EXPAND))
        v = hd(i, HGRN_HEAD_V)
        gates = []
        for d, f_pre in enumerate((f_fwd, f_bwd)):
            f_pre = hd(f_pre, HGRN_EXPAND)
            lb_d = lb[d].reshape(HGRN_HEADS, HGRN_EXPAND)
            logf = jnp.log(lb_d + (1.0 - lb_d) * jax.nn.sigmoid(f_pre))
            k = (1.0 - lb_d) * jax.nn.sigmoid(-f_pre)
            gates.append((k, logf))
        return q, v, gates, g

    qc, vc, gates_c, g_c = prep(u_ctx)
    ql, vl, gates_l, g_l = prep(u_lat)
    zero = jnp.zeros((u_ctx.shape[0], HGRN_HEADS, HGRN_EXPAND, HGRN_HEAD_V), jnp.float32)
    outs_lat, outs_ctx = [], []
    for d in range(2):
        flip = (lambda t: jnp.flip(t, axis=1)) if d == 1 else (lambda t: t)
        (kc, lfc), (kl, lfl) = gates_c[d], gates_l[d]
        oc, s_ctx = gla_chunked(flip(qc), flip(kc), flip(vc), flip(lfc), zero)
        ol, _ = gla_chunked(flip(ql), flip(kl), flip(vl), flip(lfl), s_ctx)
        outs_lat.append(flip(ol))
        outs_ctx.append(flip(oc))

    def readout(o, g, u):
        b, n, _ = u.shape
        gate = jax.nn.silu(g.reshape(b, n, HGRN_HEADS, HGRN_HEAD_V).astype(jnp.float32))
        y = rms_norm(o, norm_w) * gate
        return y.reshape(b, n, D_MODEL).astype(u.dtype) @ w_out

    m_lat = readout(outs_lat[0] + outs_lat[1], g_l, u_lat)
    m_ctx = readout(outs_ctx[0] + outs_ctx[1], g_c, u_ctx) if need_ctx else None
    return m_lat, m_ctx


def conv_ffn(u, w_up, conv_w, conv_b, w_down):
    a, v = jnp.split(u @ w_up, 2, axis=-1)
    n = a.shape[1]
    pad = CONV_W // 2
    a_pad = jnp.pad(a, ((0, 0), (pad, pad), (0, 0)))
    conv = conv_b
    for tap in range(CONV_W):
        conv = conv + a_pad[:, tap:tap + n] * conv_w[tap]
    return (jax.nn.gelu(conv, approximate=False) * v) @ w_down


def setup_inputs(seed: int = 0) -> dict:
    key = jax.random.key(seed)
    ks = jax.random.split(key, 22)
    d = D_MODEL
    nrm = lambda k, shape, scale: jax.random.normal(k, shape, jnp.float32) * scale
    return {
        'x': nrm(ks[0], (BATCH, SEQ, d), 1.0),
        'c': nrm(ks[1], (BATCH, d), 1.0),
        'ctx': nrm(ks[2], (BATCH, CTX_LEN, d), 1.0),
        'c_ctx': nrm(ks[3], (d,), 1.0),
        'mod_w': nrm(ks[4], (DEPTH, d, 6 * d), MOD_INIT * d ** -0.5),
        'mod_b': nrm(ks[5], (DEPTH, 6 * d), 0.02),
        'ln_mix_g': 1.0 + nrm(ks[6], (DEPTH, d), 0.02),
        'ln_mix_b': nrm(ks[7], (DEPTH, d), 0.02),
        'ln_ffn_g': 1.0 + nrm(ks[8], (DEPTH, d), 0.02),
        'ln_ffn_b': nrm(ks[9], (DEPTH, d), 0.02),
        'even_w_in': nrm(ks[10], (N_EVEN, d, EVEN_IN_WIDTH), d ** -0.5),
        'even_w_out': nrm(ks[11], (N_EVEN, DIFF_WIDTH + FOURIER_WIDTH, d), BETA * (DIFF_WIDTH + FOURIER_WIDTH) ** -0.5),
        'diff_lambda': nrm(ks[12], (N_EVEN, 4, DIFF_QK_DIM), 0.1),
        'diff_subln': 1.0 + nrm(ks[13], (N_EVEN, DIFF_V_DIM), 0.02),
        'hgrn_w_in': nrm(ks[14], (N_ODD, d, HGRN_IN_WIDTH), d ** -0.5),
        'hgrn_w_out': nrm(ks[15], (N_ODD, d, d), BETA * d ** -0.5),
        'hgrn_lower_bounds': nrm(ks[16], (2, DEPTH, FORGET_DIM), 1.0),
        'hgrn_norm': 1.0 + nrm(ks[17], (N_ODD, HGRN_HEAD_V), 0.02),
        'ffn_w_up': nrm(ks[18], (DEPTH, d, 2 * D_FF), d ** -0.5),
        'ffn_conv_w': nrm(ks[19], (DEPTH, CONV_W, D_FF), CONV_W ** -0.5),
        'ffn_conv_b': nrm(ks[20], (DEPTH, D_FF), 0.02),
        'ffn_w_down': nrm(ks[21], (DEPTH, D_FF, d), BETA * D_FF ** -0.5),
    }


def reference(x, c, ctx, c_ctx, mod_w, mod_b, ln_mix_g, ln_mix_b, ln_ffn_g, ln_ffn_b,
              even_w_in, even_w_out, diff_lambda, diff_subln,
              hgrn_w_in, hgrn_w_out, hgrn_lower_bounds, hgrn_norm,
              ffn_w_up, ffn_conv_w, ffn_conv_b, ffn_w_down):
    n = x.shape[1]
    rows = n // GRID_W
    row_ids = jnp.repeat(jnp.arange(rows), GRID_W)
    col_ids = jnp.tile(jnp.arange(GRID_W), rows)
    rope = rope_tables(row_ids) + rope_tables(col_ids)

    lb_all = jnp.cumsum(jax.nn.softmax(hgrn_lower_bounds.astype(jnp.float32), axis=1), axis=1)
    lb_all = lb_all - lb_all[:, :1]

    silu_c = jax.nn.silu(c)
    silu_cc = jax.nn.silu(c_ctx)
    h_lat, h_ctx = x, ctx
    for layer in range(DEPTH):
        last = layer == DEPTH - 1
        slot = layer // 2
        mod_l = (silu_c @ mod_w[layer] + mod_b[layer])[:, None, :]
        mod_c = (silu_cc @ mod_w[layer] + mod_b[layer])[None, None, :]
        sh_a, sc_a, gt_a, sh_f, sc_f, gt_f = jnp.split(mod_l, 6, axis=-1)
        csh_a, csc_a, cgt_a, csh_f, csc_f, cgt_f = jnp.split(mod_c, 6, axis=-1)
        u_lat = modulate(layer_norm(h_lat), sh_a, sc_a)
        u_ctx = modulate(layer_norm(h_ctx), csh_a, csc_a)
        if layer % 2 == 0:
            lam_init = 0.8 - 0.6 * math.exp(-0.3 * layer)
            m_lat, m_ctx = even_mixer(u_lat, u_ctx, rope, even_w_in[slot], even_w_out[slot],
                                      diff_lambda[slot], diff_subln[slot], lam_init, not last)
        else:
            m_lat, m_ctx = hgrn_mixer(u_lat, u_ctx, hgrn_w_in[slot], hgrn_w_out[slot],
                                      lb_all[:, layer], hgrn_norm[slot], not last)
        h_lat = residual_post_norm(h_lat, gt_a * m_lat, ln_mix_g[layer], ln_mix_b[layer])
        f_lat = conv_ffn(modulate(layer_norm(h_lat), sh_f, sc_f),
                         ffn_w_up[layer], ffn_conv_w[layer], ffn_conv_b[layer], ffn_w_down[layer])
        h_lat = residual_post_norm(h_lat, gt_f * f_lat, ln_ffn_g[layer], ln_ffn_b[layer])
        if not last:
            h_ctx = residual_post_norm(h_ctx, cgt_a * m_ctx, ln_mix_g[layer], ln_mix_b[layer])
            f_ctx = conv_ffn(modulate(layer_norm(h_ctx), csh_f, csc_f),
                             ffn_w_up[layer], ffn_conv_w[layer], ffn_conv_b[layer], ffn_w_down[layer])
            h_ctx = residual_post_norm(h_ctx, cgt_f * f_ctx, ln_ffn_g[layer], ln_ffn_b[layer])
    return h_lat
```

```cpp
#include <hip/hip_runtime.h>
#include <hip/hip_cooperative_groups.h>
#include <cstdio>
#include <cstdint>
namespace cg = cooperative_groups;
namespace pg8 {
#define PG8_LAS __attribute__((address_space(3)))
typedef unsigned short bf16_t;
typedef short bf16x8 __attribute__((ext_vector_type(8)));
typedef float f32x4 __attribute__((ext_vector_type(4)));
typedef unsigned u32x4 __attribute__((ext_vector_type(4)));
constexpr int BM = 256, BK = 64, HALF = 128, HTB = HALF * BK * 2  , STAGE_BYTES = 8 * HTB, NXCD = 8, WGM = 8;

__host__ __device__ __forceinline__ int lds_byte(int r, int c) { const int st = (r >> 4) * 2 + (c >> 5), rr = r & 15, cc = c & 31, ob = rr * 64 + cc * 2; return st * 1024 + (ob ^ (((ob >> 9) & 1) << 5)); }
__host__ __device__ __forceinline__ void stage_rc(int b, int& R, int& C) { const int st = b / 1024, sb = b % 1024, swz = sb ^ (((sb >> 9) & 1) << 5); R = (st >> 1) * 16 + swz / 64; C = (st & 1) * 32 + (swz % 64) / 2; }
__host__ __device__ __forceinline__ int perm32(int rho) { const int n = rho >> 4, i = rho & 15; return 8 * (i >> 2) + 4 * n + (i & 3); }

struct Unit { int pm, pn; };
struct Gemm { const bf16_t* A; const bf16_t* Bt; int M, N, K; };

struct StaticOrder {
    int nM, nN, nwg, G, c;
    __host__ __device__ void init(int M, int N, int G_, int c_) { nM = M / BM; nN = N / BM; nwg = nM * nN; G = G_; c = c_; }
    __host__ __device__ bool next(int i, Unit& u) const {
        const long L = (long)i * G + c; if (L >= nwg) return false;
        int wgid = (int)L; { const int q = nwg / NXCD, r = nwg % NXCD, xcd = wgid % NXCD, off = wgid / NXCD; wgid = (xcd < r ? xcd * (q + 1) : r * (q + 1) + (xcd - r) * q) + off; }
        const int nig = WGM * nN, gid = wgid / nig, fm = gid * WGM, gsz = (nM - fm) < WGM ? (nM - fm) : WGM;
        u.pm = fm + ((wgid % nig) % gsz); u.pn = (wgid % nig) / gsz; return true;
    }
    __device__ __forceinline__ void a_ready(const Unit&) const {}
    __device__ __forceinline__ void done(const Unit&) const {}
};
__device__ __forceinline__ unsigned cvt_pk_bf16(float lo, float hi) { unsigned r; asm volatile("v_cvt_pk_bf16_f32 %0, %1, %2" : "=v"(r) : "v"(lo), "v"(hi)); return r; }
typedef float f32x2 __attribute__((ext_vector_type(2)));
__device__ __forceinline__ f32x2 gelu_pk(f32x2 v) {
    const f32x2 av = __builtin_elementwise_abs(v), d = av * 0.2316418882f + 1.0f;
    f32x2 t; t.x = __builtin_amdgcn_rcpf(d.x); t.y = __builtin_amdgcn_rcpf(d.y);
    f32x2 q = t * 0.5307027145f + (-0.7265760135f); q = q * t + 0.7107068705f; q = q * t + (-0.142248368f); q = q * t + 0.127414796f; q = q * t;
    const f32x2 s = (v * v) * (-0.72134752044f);
    f32x2 e; e.x = __builtin_amdgcn_exp2f(s.x); e.y = __builtin_amdgcn_exp2f(s.y);
    const f32x2 m = v * (q * e), r = v - m;
    f32x2 o; o.x = v.x < 0.f ? m.x : r.x; o.y = v.y < 0.f ? m.y : r.y; return o;
}
template <class Epi, class Sched, bool ALIGN_EPI = false, bool SP2 = false>
__device__ __forceinline__ void gemm_phase(PG8_LAS unsigned char* lds, const Gemm g, const Sched& S, const Epi& E) {
    int tid_ = threadIdx.x; asm volatile("" : "+v"(tid_)); const int tid = tid_, wid = __builtin_amdgcn_readfirstlane(tid >> 6), lane = tid & 63, wr = wid >> 2, wc = wid & 3, fr = lane & 15, fq = lane >> 4;
    const int K = g.K, nt = K / BK;
    unsigned voffA[2], voffB[2];
#pragma unroll
    for (int i = 0; i < 2; ++i) { int R, C; stage_rc(tid * 16 + i * 8192, R, C); const int Rb = Epi::PERM ? ((R & ~31) + perm32(R & 31)) : R;
        voffA[i] = (unsigned)(R * K + C) * 2u; voffB[i] = (unsigned)(Rb * K + C) * 2u; }
    const size_t kstep = (size_t)(BK * 2);
    const size_t hstep = (size_t)HALF * K * 2;
    const size_t tstep = 2 * hstep;
    const unsigned ldsw = (unsigned)wid * 1024u;
    const int aoff = lds_byte(wr * 64 + fr, fq * 8), boff = lds_byte(wc * 32 + fr, fq * 8);
#define PG8_SA(b, h) (((b) * 2 + (h)) * HTB)
#define PG8_SB(b, h) ((4 + (b) * 2 + (h)) * HTB)
#define PG8_STAGE(bufoff, gbase, voff) do { _Pragma("unroll") for (int _i = 0; _i < 2; ++_i) \
        __builtin_amdgcn_global_load_lds((const unsigned*)((const char*)(gbase) + (voff)[_i]), (PG8_LAS unsigned*)(lds + (bufoff) + ldsw + _i * 8192), 16, 0, 0); } while (0)
#define PG8_LDA(dst, b, h) do { _Pragma("unroll") for (int m = 0; m < 4; ++m) _Pragma("unroll") for (int k = 0; k < 2; ++k) dst[m][k] = *(const PG8_LAS bf16x8*)(lds + PG8_SA(b, h) + aoff + m * 2048 + k * 1024); } while (0)
#define PG8_LDB(dst, b, h) do { _Pragma("unroll") for (int n = 0; n < 2; ++n) _Pragma("unroll") for (int k = 0; k < 2; ++k) dst[n][k] = *(const PG8_LAS bf16x8*)(lds + PG8_SB(b, h) + boff + n * 2048 + k * 1024); } while (0)
#define PG8_MMA(ai, bj, At, Bt) do { __builtin_amdgcn_s_setprio(1); _Pragma("unroll") for (int m = 0; m < 4; ++m) _Pragma("unroll") for (int n = 0; n < 2; ++n) _Pragma("unroll") for (int k = 0; k < 2; ++k) \
        acc[ai][bj][m][n] = __builtin_amdgcn_mfma_f32_16x16x32_bf16(Bt[n][k], At[m][k], acc[ai][bj][m][n], 0, 0, 0); __builtin_amdgcn_s_setprio(0); } while (0)
#define PG8_WAIT_V(n) asm volatile("s_waitcnt vmcnt(" #n ")" ::: "memory")
#define PG8_WAIT_L(n) asm volatile("s_waitcnt lgkmcnt(" #n ")" ::: "memory")
#define PG8_BAR __builtin_amdgcn_s_barrier()
#define PG8_SCHED __builtin_amdgcn_sched_barrier(0)
    Unit cur, nxt; int ui = 0;
    if (!S.next(0, cur)) return;
    f32x4 acc[2][2][4][2];
#pragma unroll
    for (int a = 0; a < 2; ++a)
#pragma unroll
        for (int b = 0; b < 2; ++b)
#pragma unroll
            for (int m = 0; m < 4; ++m)
#pragma unroll
                for (int n = 0; n < 2; ++n) acc[a][b][m][n] = (f32x4){0.f, 0.f, 0.f, 0.f};
    bf16x8 At[4][2], B0[2][2], B1[2][2];
    const char* cA = (const char*)g.A + (size_t)cur.pm * tstep; const char* cB = (const char*)g.Bt + (size_t)cur.pn * tstep;
    S.a_ready(cur);
    if constexpr (SP2) {
        PG8_STAGE(PG8_SB(0, 0), cB, voffB); PG8_STAGE(PG8_SB(0, 1), cB + hstep, voffB); PG8_STAGE(PG8_SA(0, 0), cA, voffA); PG8_STAGE(PG8_SA(0, 1), cA + hstep, voffA);
        if (wr == 1) PG8_BAR;
        PG8_WAIT_V(2); PG8_BAR;
        PG8_STAGE(PG8_SB(1, 0), cB + kstep, voffB); PG8_STAGE(PG8_SA(1, 0), cA + kstep, voffA); PG8_STAGE(PG8_SB(1, 1), cB + hstep + kstep, voffB);
        PG8_WAIT_V(6); PG8_BAR;
    } else {
        PG8_STAGE(PG8_SB(0, 0), cB, voffB); PG8_STAGE(PG8_SA(0, 0), cA, voffA); PG8_STAGE(PG8_SB(0, 1), cB + hstep, voffB); PG8_STAGE(PG8_SA(0, 1), cA + hstep, voffA);
        if (wr == 1) PG8_BAR;
        PG8_WAIT_V(4); PG8_BAR;
        PG8_STAGE(PG8_SB(1, 0), cB + kstep, voffB); PG8_STAGE(PG8_SA(1, 0), cA + kstep, voffA); PG8_STAGE(PG8_SB(1, 1), cB + hstep + kstep, voffB);
        PG8_WAIT_V(6); PG8_BAR;
    }
    for (;;) {
        const bool has_next = S.next(ui + 1, nxt);
        const char* nA = has_next ? (const char*)g.A + (size_t)nxt.pm * tstep : cA; const char* nB = has_next ? (const char*)g.Bt + (size_t)nxt.pn * tstep : cB;
        for (int t = 0; t < nt; t += 2) {
            const bool last = (t == nt - 2);
            const char* a1 = cA + (size_t)(t + 1) * kstep;
            const char* a2 = last ? nA : cA + (size_t)(t + 2) * kstep; const char* b2 = last ? nB : cB + (size_t)(t + 2) * kstep;
            const char* a3 = a2 + kstep; const char* b3 = b2 + kstep;
            if (last && has_next) S.a_ready(nxt);
            if constexpr (SP2) {
            PG8_LDB(B0, 0, 0); PG8_LDB(B1, 0, 1); PG8_SCHED; PG8_LDA(At, 0, 0); PG8_STAGE(PG8_SA(1, 1), a1 + hstep, voffA);
            PG8_WAIT_V(8); PG8_WAIT_L(0); PG8_BAR; PG8_MMA(0, 0, At, B0); PG8_MMA(0, 1, At, B1); PG8_BAR; PG8_SCHED;
            PG8_LDA(At, 0, 1); PG8_STAGE(PG8_SB(0, 0), b2, voffB); PG8_STAGE(PG8_SB(0, 1), b2 + hstep, voffB); PG8_STAGE(PG8_SA(0, 0), a2, voffA);
            PG8_WAIT_V(8); PG8_WAIT_L(0); PG8_BAR; PG8_MMA(1, 0, At, B0); PG8_MMA(1, 1, At, B1); PG8_BAR; PG8_SCHED;
            PG8_LDB(B0, 1, 0); PG8_LDB(B1, 1, 1); PG8_SCHED; PG8_LDA(At, 1, 0); PG8_STAGE(PG8_SA(0, 1), a2 + hstep, voffA);
            PG8_WAIT_V(8); PG8_WAIT_L(0); PG8_BAR; PG8_MMA(0, 0, At, B0); PG8_MMA(0, 1, At, B1); PG8_BAR; PG8_SCHED;
            PG8_LDA(At, 1, 1); PG8_STAGE(PG8_SB(1, 0), b3, voffB); PG8_STAGE(PG8_SB(1, 1), b3 + hstep, voffB); PG8_STAGE(PG8_SA(1, 0), a3, voffA);
            PG8_WAIT_V(8); PG8_WAIT_L(0); PG8_BAR; PG8_MMA(1, 0, At, B0); PG8_MMA(1, 1, At, B1); PG8_BAR; PG8_SCHED;
            } else {
            PG8_LDB(B0, 0, 0); PG8_SCHED; PG8_LDA(At, 0, 0); PG8_STAGE(PG8_SA(1, 1), a1 + hstep, voffA);
            PG8_WAIT_L(8); PG8_BAR; PG8_WAIT_L(0); PG8_MMA(0, 0, At, B0); PG8_BAR; PG8_SCHED;
            PG8_LDB(B1, 0, 1); PG8_STAGE(PG8_SB(0, 0), b2, voffB);
            PG8_BAR; PG8_WAIT_L(0); PG8_MMA(0, 1, At, B1); PG8_BAR;
            PG8_LDA(At, 0, 1); PG8_STAGE(PG8_SA(0, 0), a2, voffA);
            PG8_BAR; PG8_WAIT_L(0); PG8_MMA(1, 0, At, B0); PG8_BAR; PG8_SCHED;
            PG8_STAGE(PG8_SB(0, 1), b2 + hstep, voffB);
            PG8_WAIT_V(6); PG8_BAR; PG8_MMA(1, 1, At, B1); PG8_BAR;
            PG8_LDB(B0, 1, 0); PG8_SCHED; PG8_LDA(At, 1, 0); PG8_STAGE(PG8_SA(0, 1), a2 + hstep, voffA);
            PG8_WAIT_L(8); PG8_BAR; PG8_WAIT_L(0); PG8_MMA(0, 0, At, B0); PG8_BAR; PG8_SCHED;
            PG8_LDB(B1, 1, 1); PG8_STAGE(PG8_SB(1, 0), b3, voffB);
            PG8_BAR; PG8_WAIT_L(0); PG8_MMA(0, 1, At, B1); PG8_BAR;
            PG8_LDA(At, 1, 1); PG8_STAGE(PG8_SA(1, 0), a3, voffA);
            PG8_BAR; PG8_WAIT_L(0); PG8_MMA(1, 0, At, B0); PG8_BAR; PG8_SCHED;
            PG8_STAGE(PG8_SB(1, 1), b3 + hstep, voffB);
            PG8_WAIT_V(6); PG8_BAR; PG8_MMA(1, 1, At, B1); PG8_BAR;
            }
        }
        if constexpr (ALIGN_EPI) { if (wr == 0) PG8_BAR; }
        if constexpr (!Epi::AFTER_DRAIN) { E(acc, cur, wr, wc, fr, fq); S.done(cur); }
        if (!has_next) break;
#pragma unroll
        for (int a = 0; a < 2; ++a)
#pragma unroll
            for (int b = 0; b < 2; ++b)
#pragma unroll
                for (int m = 0; m < 4; ++m)
#pragma unroll
                    for (int n = 0; n < 2; ++n) acc[a][b][m][n] = (f32x4){0.f, 0.f, 0.f, 0.f};
        cur = nxt; cA = nA; cB = nB; ++ui;
        if constexpr (ALIGN_EPI) { if (wr == 1) PG8_BAR; }
    }
    PG8_WAIT_V(0);
    if constexpr (!ALIGN_EPI) { if (wr == 0) PG8_BAR; }
    PG8_BAR;
    if constexpr (Epi::AFTER_DRAIN) { E.fused(acc, cur, wr, wc, fr, fq, lds, wid, lane); S.done(cur); }
#undef PG8_SA
#undef PG8_SB
#undef PG8_STAGE
#undef PG8_LDA
#undef PG8_LDB
#undef PG8_MMA
#undef PG8_WAIT_V
#undef PG8_WAIT_L
#undef PG8_BAR
#undef PG8_SCHED
}
}

using pg8::bf16_t; using pg8::bf16x8; using pg8::f32x4; using pg8::u32x4; using pg8::Unit;
typedef _Float16 h16x8 __attribute__((ext_vector_type(8)));
typedef unsigned u32x2 __attribute__((ext_vector_type(2)));
#ifndef PROBE
#define PROBE 0
#endif
constexpr bool GEMM_ALIGN = true, GEMM_SP2 = true;
constexpr int DM = 2048, NBATCH = 8, SEQ = 2048, CTXL = 256, MLAT = NBATCH * SEQ, MCTX = NBATCH * CTXL, MTOT = MLAT + MCTX;
constexpr int DFF = 5504, NMOD = 6 * DM;
constexpr float ALPHA_F = 1.4142135623730951f;
constexpr float LN_EPS_F = 1e-6f, RMS_EPS_F = 1e-5f;
constexpr float LAM_INIT0 = 0.2f;
constexpr float QSCALE = 0.125f * 1.4426950408889634f;

constexpr size_t MiB = 1u << 20;
constexpr size_t WS_CTL = 0;
constexpr size_t WS_MODV = 1 * MiB;
constexpr size_t WS_ROPE = 2 * MiB;
constexpr size_t WS_W0QK = 4 * MiB;
constexpr size_t WS_W0VF = 16 * MiB;
constexpr size_t WS_W0OUT = 26 * MiB;
constexpr size_t WS_W1A = 34 * MiB;
constexpr size_t WS_W1V = 66 * MiB;
constexpr size_t WS_W1OUT = 74 * MiB;
constexpr size_t WS_WUP = 82 * MiB;
constexpr size_t WS_WDN = 168 * MiB;
constexpr size_t WS_D2 = 211 * MiB;
constexpr size_t WS_D2C = 227 * MiB;
constexpr size_t WS_HCTX = 228 * MiB;
constexpr size_t WS_U = 244 * MiB;
constexpr size_t WS_R = 316 * MiB;
constexpr size_t WS_END = 768 * MiB;
constexpr size_t R_QK = WS_R;
constexpr size_t R_VT0 = WS_R + 108 * MiB;
constexpr size_t R_FTL = WS_R + 162 * MiB;
constexpr size_t R_FTC = WS_R + 194 * MiB;
constexpr size_t R_CAT = WS_R + 198 * MiB;
constexpr size_t R_A1 = WS_R;
constexpr size_t R_V1 = WS_R + 194 * MiB;
constexpr size_t R_MB = WS_R + 272 * MiB;
constexpr size_t R_EDGE = WS_R + 390 * MiB;
constexpr size_t R_Q1 = WS_R;
constexpr size_t R_LF = WS_R + 72 * MiB;
constexpr size_t R_G1 = WS_R + 216 * MiB;
constexpr size_t R_VT1 = WS_R + 288 * MiB;
constexpr size_t R_OB = WS_R + 360 * MiB;

constexpr int LDS_BYTES = 152576;
constexpr int LDS_MISC = 147456;

struct Args {
    const float* in[22]; float* out; unsigned char* ws; int dbg; int pad;
};

__device__ __forceinline__ float bf2f(unsigned short v) { return __builtin_bit_cast(float, (unsigned)v << 16); }
__device__ __forceinline__ unsigned f2bf(float f) { return pg8::cvt_pk_bf16(f, f) & 0xffffu; }
__device__ __forceinline__ unsigned pk2(float lo, float hi) { return pg8::cvt_pk_bf16(lo, hi); }
__device__ __forceinline__ float wave_sum(float v) {
#pragma unroll
    for (int o = 1; o < 64; o <<= 1) v += __shfl_xor(v, o);
    return v;
}
__device__ __forceinline__ float silu_f(float x) { return x * __builtin_amdgcn_rcpf(1.0f + __expf(-x)); }
__device__ __forceinline__ float sigmoid_f(float x) { return __builtin_amdgcn_rcpf(1.0f + __expf(-x)); }
__device__ __forceinline__ float gelu_f(float v) {
    const float av = fabsf(v), t = __builtin_amdgcn_rcpf(av * 0.2316418882f + 1.0f);
    float q = t * 0.5307027145f + (-0.7265760135f); q = q * t + 0.7107068705f; q = q * t + (-0.142248368f); q = q * t + 0.127414796f; q = q * t;
    const float e = __builtin_amdgcn_exp2f((v * v) * (-0.72134752044f));
    const float m = v * (q * e);
    return v < 0.f ? m : v - m;
}

struct EpiQK {
    static constexpr bool PERM = true, AFTER_DRAIN = false;
    bf16_t* O; const float* rope;
    __device__ __forceinline__ void operator()(const f32x4 (&acc)[2][2][4][2], const Unit& u, int wr, int wc, int fr, int fq) const {
        const int row0 = u.pm * 256 + wr * 64 + fr;
        const int colt = u.pn * 256;
        const bool isq = colt < 1536;
        const float sc = isq ? QSCALE : 1.0f;
        const bool lat = (u.pm < 64);
        const int axis = wc & 1;
        const bool second = fq >= 2;
        const int i0 = 8 * (fq & 1);
#pragma unroll
        for (int ai = 0; ai < 2; ++ai)
#pragma unroll
            for (int m = 0; m < 4; ++m) {
                const int row = row0 + ai * 128 + m * 16;
                f32x4 c0 = {1.f, 1.f, 1.f, 1.f}, c1 = c0, s0 = {0.f, 0.f, 0.f, 0.f}, s1 = s0;
                if (lat) {
                    const int t = row & 2047, pos = axis ? (t & 63) : (t >> 6);
                    const float* cp = rope + pos * 16 + i0;
                    c0 = *(const f32x4*)cp; c1 = *(const f32x4*)(cp + 4); s0 = *(const f32x4*)(cp + 1024); s1 = *(const f32x4*)(cp + 1028);
                }
                bf16_t* rowp = O + (size_t)row * 3072 + colt + wc * 32 + 8 * fq;
#pragma unroll
                for (int bj = 0; bj < 2; ++bj) {
                    f32x4 v0 = acc[ai][bj][m][0], v1 = acc[ai][bj][m][1];
                    if (lat) {
                        f32x4 p0, p1;
#pragma unroll
                        for (int j = 0; j < 4; ++j) { p0[j] = __shfl_xor(v0[j], 32); p1[j] = __shfl_xor(v1[j], 32); }
                        if (second) { v0 = v0 * c0 + p0 * s0; v1 = v1 * c1 + p1 * s1; }
                        else        { v0 = v0 * c0 - p0 * s0; v1 = v1 * c1 - p1 * s1; }
                    }
                    v0 = v0 * sc; v1 = v1 * sc;
                    u32x4 w; w.x = pg8::cvt_pk_bf16(v0[0], v0[1]); w.y = pg8::cvt_pk_bf16(v0[2], v0[3]); w.z = pg8::cvt_pk_bf16(v1[0], v1[1]); w.w = pg8::cvt_pk_bf16(v1[2], v1[3]);
                    *(u32x4*)(rowp + bj * 128) = w;
                }
            }
    }
};
struct EpiT {
    static constexpr bool PERM = true, AFTER_DRAIN = false;
    bf16_t* VT; bf16_t* FTL; bf16_t* FTC; int mode;
    __device__ __forceinline__ void operator()(const f32x4 (&acc)[2][2][4][2], const Unit& u, int wr, int wc, int fr, int fq) const {
        const int row0 = u.pm * 256 + wr * 64 + fr;
        const int col0 = u.pn * 256 + wc * 32 + 8 * fq;
#pragma unroll
        for (int ai = 0; ai < 2; ++ai)
#pragma unroll
            for (int m = 0; m < 4; ++m) {
                const int row = row0 + ai * 128 + m * 16;
#pragma unroll
                for (int bj = 0; bj < 2; ++bj) {
                    const int col = col0 + bj * 128;
                    const f32x4 v0 = acc[ai][bj][m][0], v1 = acc[ai][bj][m][1];
                    u32x4 w; w.x = pg8::cvt_pk_bf16(v0[0], v0[1]); w.y = pg8::cvt_pk_bf16(v0[2], v0[3]); w.z = pg8::cvt_pk_bf16(v1[0], v1[1]); w.w = pg8::cvt_pk_bf16(v1[2], v1[3]);
                    bf16_t* dst;
                    if (mode == 1 || row < 1536) dst = VT + (size_t)row * MTOT + col;
                    else {
                        const int rr = row - 1536, part = rr >> 9, j = rr & 511;
                        if (col < MLAT) { const int b = col >> 11, t = col & 2047; dst = FTL + ((size_t)(b * 512 + j) * 4096 + part * 2048 + t); }
                        else { const int cc = col - MLAT, b = cc >> 8, t = cc & 255; dst = FTC + ((size_t)(b * 512 + j) * 512 + part * 256 + t); }
                    }
                    *(u32x4*)dst = w;
                }
            }
    }
};
struct EpiFour {
    static constexpr bool PERM = true, AFTER_DRAIN = false;
    bf16_t* CAT; int rowbase, L; float scale;
    __device__ __forceinline__ void operator()(const f32x4 (&acc)[2][2][4][2], const Unit& u, int wr, int wc, int fr, int fq) const {
        const int row0 = u.pm * 256 + wr * 64 + fr;
        const int b = u.pn >> 1;
        const int j0 = (u.pn & 1) * 256 + wc * 32 + 8 * fq;
#pragma unroll
        for (int ai = 0; ai < 2; ++ai)
#pragma unroll
            for (int m = 0; m < 4; ++m) {
                const int k = row0 + ai * 128 + m * 16;
                bf16_t* rowp = CAT + (size_t)(rowbase + b * L + k) * 2048 + 1536 + j0;
#pragma unroll
                for (int bj = 0; bj < 2; ++bj) {
                    const f32x4 v0 = acc[ai][bj][m][0] * scale, v1 = acc[ai][bj][m][1] * scale;
                    u32x4 w; w.x = pg8::cvt_pk_bf16(v0[0], v0[1]); w.y = pg8::cvt_pk_bf16(v0[2], v0[3]); w.z = pg8::cvt_pk_bf16(v1[0], v1[1]); w.w = pg8::cvt_pk_bf16(v1[2], v1[3]);
                    *(u32x4*)(rowp + bj * 128) = w;
                }
            }
    }
};
struct EpiResid {
    static constexpr bool PERM = true, AFTER_DRAIN = false;
    bf16_t* MB; const float* gate;
    __device__ __forceinline__ void operator()(const f32x4 (&acc)[2][2][4][2], const Unit& u, int wr, int wc, int fr, int fq) const {
        const int row0 = u.pm * 256 + wr * 64 + fr, col0 = u.pn * 256 + wc * 32 + 8 * fq;
        const int r = u.pm < 64 ? (u.pm >> 3) : 8;
        const float* gp = gate + r * NMOD + col0;
        f32x4 g[2][2];
#pragma unroll
        for (int bj = 0; bj < 2; ++bj)
#pragma unroll
            for (int n = 0; n < 2; ++n) g[bj][n] = *(const f32x4*)(gp + bj * 128 + 4 * n);
#pragma unroll
        for (int ai = 0; ai < 2; ++ai)
#pragma unroll
            for (int m = 0; m < 4; ++m) {
                bf16_t* rowp = MB + (size_t)(row0 + ai * 128 + m * 16) * DM + col0;
#pragma unroll
                for (int bj = 0; bj < 2; ++bj) {
                    const f32x4 v0 = acc[ai][bj][m][0] * g[bj][0], v1 = acc[ai][bj][m][1] * g[bj][1];
                    u32x4 w; w.x = pg8::cvt_pk_bf16(v0[0], v0[1]); w.y = pg8::cvt_pk_bf16(v0[2], v0[3]); w.z = pg8::cvt_pk_bf16(v1[0], v1[1]); w.w = pg8::cvt_pk_bf16(v1[2], v1[3]);
                    *(u32x4*)(rowp + bj * 128) = w;
                }
            }
    }
};
struct EpiUp {
    static constexpr bool PERM = true, AFTER_DRAIN = false;
    bf16_t* A1; bf16_t* V1;
    __device__ __forceinline__ void operator()(const f32x4 (&acc)[2][2][4][2], const Unit& u, int wr, int wc, int fr, int fq) const {
        const int row0 = u.pm * 256 + wr * 64 + fr, col0 = u.pn * 128 + wc * 32 + 8 * fq;
#pragma unroll
        for (int ai = 0; ai < 2; ++ai)
#pragma unroll
            for (int m = 0; m < 4; ++m) {
                const size_t off = (size_t)(row0 + ai * 128 + m * 16) * DFF + col0;
#pragma unroll
                for (int bj = 0; bj < 2; ++bj) {
                    const f32x4 v0 = acc[ai][bj][m][0], v1 = acc[ai][bj][m][1];
                    u32x4 w; w.x = pg8::cvt_pk_bf16(v0[0], v0[1]); w.y = pg8::cvt_pk_bf16(v0[2], v0[3]); w.z = pg8::cvt_pk_bf16(v1[0], v1[1]); w.w = pg8::cvt_pk_bf16(v1[2], v1[3]);
                    *(u32x4*)((bj ? V1 : A1) + off) = w;
                }
            }
    }
};
__device__ __forceinline__ float dpp_ror1(float x) { return __builtin_bit_cast(float, __builtin_amdgcn_update_dpp(0, __builtin_bit_cast(int, x), 0x121, 0xf, 0xf, false)); }
__device__ __forceinline__ float dpp_rol1(float x) { return __builtin_bit_cast(float, __builtin_amdgcn_update_dpp(0, __builtin_bit_cast(int, x), 0x12F, 0xf, 0xf, false)); }
struct EpiUpFused {
    static constexpr bool PERM = true, AFTER_DRAIN = false;
    bf16_t* HID; float* EA; float* EP; float* EV; const float* cw; const float* cb; float* xch;
    __device__ __forceinline__ void operator()(const f32x4 (&acc)[2][2][4][2], const Unit& u, int wr, int wc, int fr, int fq) const {
        const int lc0 = wc * 32 + 8 * fq, col0 = u.pn * 128 + lc0;
        const int row0 = u.pm * 256 + wr * 64 + fr;
#pragma unroll
        for (int ai = 0; ai < 2; ++ai) {
            const int sg = ai * 2 + wr;
            if (fr == 0) { *(f32x4*)(xch + (sg * 2 + 0) * 128 + lc0) = acc[ai][0][0][0]; *(f32x4*)(xch + (sg * 2 + 0) * 128 + lc0 + 4) = acc[ai][0][0][1]; }
            if (fr == 15) { *(f32x4*)(xch + (sg * 2 + 1) * 128 + lc0) = acc[ai][0][3][0]; *(f32x4*)(xch + (sg * 2 + 1) * 128 + lc0 + 4) = acc[ai][0][3][1]; }
        }
        asm volatile("s_waitcnt lgkmcnt(0)" ::: "memory");
        __builtin_amdgcn_s_barrier();
        asm volatile("" ::: "memory");
        f32x4 w0[2], w1[2], w2[2], bb[2];
#pragma unroll
        for (int n = 0; n < 2; ++n) { w0[n] = *(const f32x4*)(cw + col0 + 4 * n); w1[n] = *(const f32x4*)(cw + DFF + col0 + 4 * n); w2[n] = *(const f32x4*)(cw + 2 * DFF + col0 + 4 * n); bb[n] = *(const f32x4*)(cb + col0 + 4 * n); }
#pragma unroll
        for (int ai = 0; ai < 2; ++ai) {
            const int sg = ai * 2 + wr;
            f32x4 extp[2], extn[2];
#pragma unroll
            for (int n = 0; n < 2; ++n) {
                extp[n] = sg > 0 ? *(const f32x4*)(xch + ((sg - 1) * 2 + 1) * 128 + lc0 + 4 * n) : (f32x4){0.f, 0.f, 0.f, 0.f};
                extn[n] = sg < 3 ? *(const f32x4*)(xch + ((sg + 1) * 2 + 0) * 128 + lc0 + 4 * n) : (f32x4){0.f, 0.f, 0.f, 0.f};
            }
            f32x4 hid[4][2], cvs[4][2];
#pragma unroll
            for (int n = 0; n < 2; ++n)
#pragma unroll
                for (int j = 0; j < 4; ++j) {
                    float a[4], r[4], l[4];
#pragma unroll
                    for (int m = 0; m < 4; ++m) { a[m] = acc[ai][0][m][n][j]; r[m] = dpp_ror1(a[m]); l[m] = dpp_rol1(a[m]); }
#pragma unroll
                    for (int m = 0; m < 4; ++m) {
                        const float pv = fr > 0 ? r[m] : (m > 0 ? r[m > 0 ? m - 1 : 0] : extp[n][j]);
                        const float nv = fr < 15 ? l[m] : (m < 3 ? l[m < 3 ? m + 1 : 3] : extn[n][j]);
                        const float cv = bb[n][j] + pv * w0[n][j] + a[m] * w1[n][j] + nv * w2[n][j];
                        cvs[m][n][j] = cv;
                        hid[m][n][j] = gelu_f(cv) * acc[ai][1][m][n][j];
                    }
                }
#pragma unroll
            for (int m = 0; m < 4; ++m) {
                u32x4 w; w.x = pg8::cvt_pk_bf16(hid[m][0][0], hid[m][0][1]); w.y = pg8::cvt_pk_bf16(hid[m][0][2], hid[m][0][3]); w.z = pg8::cvt_pk_bf16(hid[m][1][0], hid[m][1][1]); w.w = pg8::cvt_pk_bf16(hid[m][1][2], hid[m][1][3]);
                *(u32x4*)(HID + (size_t)(row0 + ai * 128 + m * 16) * DFF + col0) = w;
            }
            if (sg == 0 && fr == 0) {
                const size_t eo = (size_t)(u.pm * 2 + 0) * DFF + col0;
#pragma unroll
                for (int n = 0; n < 2; ++n) { *(f32x4*)(EA + eo + 4 * n) = acc[ai][0][0][n]; *(f32x4*)(EP + eo + 4 * n) = cvs[0][n]; *(f32x4*)(EV + eo + 4 * n) = acc[ai][1][0][n]; }
            }
            if (sg == 3 && fr == 15) {
                const size_t eo = (size_t)(u.pm * 2 + 1) * DFF + col0;
#pragma unroll
                for (int n = 0; n < 2; ++n) { *(f32x4*)(EA + eo + 4 * n) = acc[ai][0][3][n]; *(f32x4*)(EP + eo + 4 * n) = cvs[3][n]; *(f32x4*)(EV + eo + 4 * n) = acc[ai][1][3][n]; }
            }
        }
    }
};
struct EpiH1 {
    static constexpr bool PERM = true, AFTER_DRAIN = false;
    bf16_t* Q1; _Float16* LF; bf16_t* G1; const float* lbraw; int row_off, pn_off;
    __device__ __forceinline__ void operator()(const f32x4 (&acc)[2][2][4][2], const Unit& u, int wr, int wc, int fr, int fq) const {
        const int row0 = row_off + u.pm * 256 + wr * 64 + fr;
        const int pnn = u.pn + pn_off;
        const int seg = pnn >> 3;
        const int cs0 = (pnn & 7) * 256 + wc * 32 + 8 * fq;
        if (seg == 0 || seg == 3) {
            bf16_t* O = seg == 0 ? Q1 : G1;
#pragma unroll
            for (int ai = 0; ai < 2; ++ai)
#pragma unroll
                for (int m = 0; m < 4; ++m) {
                    bf16_t* rowp = O + (size_t)(row0 + ai * 128 + m * 16) * DM + cs0;
#pragma unroll
                    for (int bj = 0; bj < 2; ++bj) {
                        f32x4 v0 = acc[ai][bj][m][0], v1 = acc[ai][bj][m][1];
#pragma unroll
                        for (int j = 0; j < 4; ++j) { v0[j] = silu_f(v0[j]); v1[j] = silu_f(v1[j]); }
                        u32x4 w; w.x = pg8::cvt_pk_bf16(v0[0], v0[1]); w.y = pg8::cvt_pk_bf16(v0[2], v0[3]); w.z = pg8::cvt_pk_bf16(v1[0], v1[1]); w.w = pg8::cvt_pk_bf16(v1[2], v1[3]);
                        *(u32x4*)(rowp + bj * 128) = w;
                    }
                }
        } else {
            const int d = seg - 1;
            _Float16* O = LF + (size_t)d * MTOT * DM;
            float lb[2][8];
#pragma unroll
            for (int bj = 0; bj < 2; ++bj)
#pragma unroll
                for (int e = 0; e < 8; ++e) {
                    const int c = cs0 + bj * 128 + e;
                    lb[bj][e] = sigmoid_f(lbraw[(d * 2 + 1) * DM + c] - lbraw[(d * 2 + 0) * DM + c]);
                }
#pragma unroll
            for (int ai = 0; ai < 2; ++ai)
#pragma unroll
                for (int m = 0; m < 4; ++m) {
                    _Float16* rowp = O + (size_t)(row0 + ai * 128 + m * 16) * DM + cs0;
#pragma unroll
                    for (int bj = 0; bj < 2; ++bj) {
                        h16x8 w;
#pragma unroll
                        for (int e = 0; e < 8; ++e) {
                            const float x = (e < 4) ? acc[ai][bj][m][0][e & 3] : acc[ai][bj][m][1][e & 3];
                            const float f = lb[bj][e] + (1.0f - lb[bj][e]) * sigmoid_f(x);
                            w[e] = (_Float16)__logf(f);
                        }
                        *(h16x8*)(rowp + bj * 128) = w;
                    }
                }
        }
    }
};

#define LDS_WAIT() asm volatile("s_waitcnt lgkmcnt(0)" ::: "memory")
__device__ __forceinline__ void transpose_item(const float* W, int ldw, int k0, int n0, bf16_t* WT, int K, int drow0, float* scr, int lane) {
    f32x4 v[8];
    const int kr = lane >> 3, c4 = (lane & 7) * 4;
#pragma unroll
    for (int i = 0; i < 8; ++i) v[i] = *(const f32x4*)(W + (size_t)(k0 + kr + 8 * i) * ldw + n0 + c4);
#pragma unroll
    for (int i = 0; i < 8; ++i) { float* s = scr + (kr + 8 * i) * 33 + c4; s[0] = v[i][0]; s[1] = v[i][1]; s[2] = v[i][2]; s[3] = v[i][3]; }
    LDS_WAIT(); asm volatile("" ::: "memory");
    const int c = lane & 7;
#pragma unroll
    for (int j = 0; j < 4; ++j) { const int n = (lane >> 3) + 8 * j; const float* s = scr + (8 * c) * 33 + n;
        u32x4 o; o.x = pk2(s[0 * 33], s[1 * 33]); o.y = pk2(s[2 * 33], s[3 * 33]); o.z = pk2(s[4 * 33], s[5 * 33]); o.w = pk2(s[6 * 33], s[7 * 33]);
        *(u32x4*)(WT + (size_t)(drow0 + n) * K + k0 + 8 * c) = o; }
    LDS_WAIT(); asm volatile("" ::: "memory");
}
struct TJob { const float* W; int ldw, K, ncols, col0; bf16_t* WT; int mode; };
__device__ __forceinline__ int tjob_items(const TJob& j) { return (j.K / 64) * (j.ncols / 32); }
__device__ __forceinline__ void tjob_run(const TJob& j, int drow_base, int it, float* scr, int lane) {
    const int nblk = j.ncols / 32, kb = it / nblk, nb = it % nblk;
    const int n = nb * 32;
    int drow;
    if (j.mode == 0) drow = drow_base + n;
    else { const int bj = n / DFF, r = n % DFF, pn = r >> 7, i = r & 127; drow = 256 * pn + 128 * bj + i; }
    transpose_item(j.W, j.ldw, kb * 64, j.col0 + n, j.WT, j.K, drow, scr, lane);
}

__device__ __forceinline__ void row_op(const float* zrow, float* hrow, const float* g, const float* bt, bool ln1, const float* sh, const float* sc, bf16_t* urow, int lane, const bf16_t* mrow = nullptr) {
    f32x4 v[8];
    const f32x4* zr = (const f32x4*)zrow + lane;
#pragma unroll
    for (int j = 0; j < 8; ++j) v[j] = zr[64 * j];
    if (mrow) {
#pragma unroll
        for (int j = 0; j < 8; ++j) {
            const u32x2 mw = *((const u32x2*)mrow + lane + 64 * j);
            v[j][0] = v[j][0] * ALPHA_F + bf2f((unsigned short)(mw.x & 0xffffu)); v[j][1] = v[j][1] * ALPHA_F + bf2f((unsigned short)(mw.x >> 16));
            v[j][2] = v[j][2] * ALPHA_F + bf2f((unsigned short)(mw.y & 0xffffu)); v[j][3] = v[j][3] * ALPHA_F + bf2f((unsigned short)(mw.y >> 16));
        }
    }
    if (ln1) {
        float s = 0.f;
#pragma unroll
        for (int j = 0; j < 8; ++j) s += (v[j][0] + v[j][1]) + (v[j][2] + v[j][3]);
        const float mean = wave_sum(s) * (1.f / DM); float s2 = 0.f;
#pragma unroll
        for (int j = 0; j < 8; ++j) { v[j] = v[j] - mean; s2 += (v[j][0] * v[j][0] + v[j][1] * v[j][1]) + (v[j][2] * v[j][2] + v[j][3] * v[j][3]); }
        const float rstd = 1.f / sqrtf(wave_sum(s2) * (1.f / DM) + LN_EPS_F);
#pragma unroll
        for (int j = 0; j < 8; ++j) { const f32x4 gg = *((const f32x4*)g + lane + 64 * j), bb = *((const f32x4*)bt + lane + 64 * j); v[j] = v[j] * rstd * gg + bb; }
        if (hrow) {
#pragma unroll
            for (int j = 0; j < 8; ++j) *((f32x4*)hrow + lane + 64 * j) = v[j];
        }
    }
    if (urow) {
        float s = 0.f;
#pragma unroll
        for (int j = 0; j < 8; ++j) s += (v[j][0] + v[j][1]) + (v[j][2] + v[j][3]);
        const float mean = wave_sum(s) * (1.f / DM); float s2 = 0.f;
#pragma unroll
        for (int j = 0; j < 8; ++j) { v[j] = v[j] - mean; s2 += (v[j][0] * v[j][0] + v[j][1] * v[j][1]) + (v[j][2] * v[j][2] + v[j][3] * v[j][3]); }
        const float rstd = 1.f / sqrtf(wave_sum(s2) * (1.f / DM) + LN_EPS_F);
#pragma unroll
        for (int j = 0; j < 8; ++j) {
            const f32x4 scv = *((const f32x4*)sc + lane + 64 * j), shv = *((const f32x4*)sh + lane + 64 * j);
            const f32x4 o = v[j] * rstd * (scv + 1.0f) + shv;
            u32x2 w; w.x = pk2(o[0], o[1]); w.y = pk2(o[2], o[3]);
            *((u32x2*)urow + lane + 64 * j) = w;
        }
    }
}

__device__ __forceinline__ void attn_unit(unsigned char* lds, const bf16_t* QK, const bf16_t* VT0, bf16_t* CAT, const float* subln, float lam, int unit) {
    int tid_ = threadIdx.x; asm volatile("" : "+v"(tid_)); const int tid = tid_, lane = tid & 63, wave = tid >> 6, fr = lane & 15, fq = lane >> 4;
    const int qg = wave >> 1, sm = wave & 1;
    int b, h, qrow0, ntiles;
    int rot = 0;
    if (unit < 1536) { b = unit / 192; const int rem = unit % 192; h = rem >> 4; qrow0 = b * SEQ + (rem & 15) * 128; ntiles = 36; rot = ((rem & 15) * 9) >> 2; }
    else { const int uu = unit - 1536; b = uu / 24; const int rem = uu % 24; h = rem >> 1; qrow0 = MLAT + b * CTXL + (rem & 1) * 128; ntiles = 4; }
    bf16_t* Kt0 = (bf16_t*)lds;
    float* XO = (float*)lds;
    bf16x8 q[2][2];
#pragma unroll
    for (int qt = 0; qt < 2; ++qt)
#pragma unroll
        for (int kk = 0; kk < 2; ++kk)
            q[qt][kk] = *(const bf16x8*)(QK + (size_t)(qrow0 + qg * 32 + qt * 16 + fr) * 3072 + h * 128 + sm * 64 + kk * 32 + fq * 8);
    f32x4 O[2][8];
#pragma unroll
    for (int qt = 0; qt < 2; ++qt)
#pragma unroll
        for (int dt = 0; dt < 8; ++dt) O[qt][dt] = (f32x4){0.f, 0.f, 0.f, 0.f};
    float mrun[2] = {-INFINITY, -INFINITY}, lrun[2] = {0.f, 0.f};
    u32x4 kreg[2], vreg[2];
#define keyrow_(i) ((i) < 4 ? (MLAT + b * CTXL + 64 * (i)) : (b * SEQ + 64 * ((i) - 4)))
#define keyrow(i) keyrow_(((i) + rot) % ntiles)
#define AT_LOAD(i_) do { const int kr0 = keyrow(i_); _Pragma("unroll") for (int c = 0; c < 2; ++c) { const int id = tid + 512 * c; \
            kreg[c] = *(const u32x4*)(QK + (size_t)(kr0 + (id >> 4)) * 3072 + 1536 + h * 128 + (id & 15) * 8); \
            vreg[c] = *(const u32x4*)(VT0 + (size_t)(h * 128 + (id >> 3)) * MTOT + kr0 + (id & 7) * 8); } } while (0)
#define AT_STORE(buf_) do { bf16_t* Kb = Kt0 + (buf_) * 18432; bf16_t* Vb = Kb + 8704; _Pragma("unroll") for (int c = 0; c < 2; ++c) { const int id = tid + 512 * c; \
            *(u32x4*)(Kb + (id >> 4) * 136 + (id & 15) * 8) = kreg[c]; \
            *(u32x4*)(Vb + (id >> 3) * 72 + (id & 7) * 8) = vreg[c]; } } while (0)
    __syncthreads();
    AT_LOAD(0); AT_STORE(0);
    if (ntiles > 1) AT_LOAD(1);
    __syncthreads();
    const bool grpB = wave >= 4;
    bf16x8 pb[2][2];
#define AT_PV(Vt_) do { _Pragma("unroll") for (int hf = 0; hf < 2; ++hf) { bf16x8 av_[8]; \
        _Pragma("unroll") for (int d4 = 0; d4 < 4; ++d4) _Pragma("unroll") for (int kk = 0; kk < 2; ++kk) { const int dt = hf * 4 + d4; \
            const u32x2 lo = *(const u32x2*)((Vt_) + (dt * 16 + fr) * 72 + kk * 32 + 4 * fq); \
            const u32x2 hi = *(const u32x2*)((Vt_) + (dt * 16 + fr) * 72 + kk * 32 + 16 + 4 * fq); \
            u32x4 w; w.x = lo.x; w.y = lo.y; w.z = hi.x; w.w = hi.y; av_[d4 * 2 + kk] = __builtin_bit_cast(bf16x8, w); } \
        __builtin_amdgcn_sched_barrier(0); \
        _Pragma("unroll") for (int d4 = 0; d4 < 4; ++d4) _Pragma("unroll") for (int kk = 0; kk < 2; ++kk) \
            _Pragma("unroll") for (int qt = 0; qt < 2; ++qt) O[qt][hf * 4 + d4] = __builtin_amdgcn_mfma_f32_16x16x32_bf16(av_[d4 * 2 + kk], pb[qt][kk], O[qt][hf * 4 + d4], 0, 0, 0); \
        __builtin_amdgcn_sched_barrier(0); } } while (0)
    int rb = 0;
    for (int i = 0; i <= ntiles; ++i) {
        const int rbn = rb == 2 ? 0 : rb + 1, rbp = rb == 0 ? 2 : rb - 1;
        const bf16_t* Kt = Kt0 + rb * 18432;
        if (i + 1 < ntiles) AT_STORE(rbn);
        if (i + 2 < ntiles) AT_LOAD(i + 2);
        if (grpB && i > 0) AT_PV(Kt0 + rbp * 18432 + 8704);
        if (i < ntiles) {
        f32x4 s[4][2];
#pragma unroll
        for (int kt = 0; kt < 4; ++kt) {
            const bf16x8 a0 = *(const bf16x8*)(Kt + (kt * 16 + fr) * 136 + sm * 64 + fq * 8);
            const bf16x8 a1 = *(const bf16x8*)(Kt + (kt * 16 + fr) * 136 + sm * 64 + 32 + fq * 8);
#pragma unroll
            for (int qt = 0; qt < 2; ++qt) {
                f32x4 z = {0.f, 0.f, 0.f, 0.f};
                z = __builtin_amdgcn_mfma_f32_16x16x32_bf16(a0, q[qt][0], z, 0, 0, 0);
                s[kt][qt] = __builtin_amdgcn_mfma_f32_16x16x32_bf16(a1, q[qt][1], z, 0, 0, 0);
            }
        }
#pragma unroll
        for (int qt = 0; qt < 2; ++qt) {
            float mx = -INFINITY;
#pragma unroll
            for (int kt = 0; kt < 4; ++kt)
#pragma unroll
                for (int j = 0; j < 4; ++j) mx = fmaxf(mx, s[kt][qt][j]);
            if (__builtin_amdgcn_ballot_w64(mx > mrun[qt] + 40.0f) != 0ull) {
                mx = fmaxf(mx, __shfl_xor(mx, 16)); mx = fmaxf(mx, __shfl_xor(mx, 32));
                const float mnew = fmaxf(mrun[qt], mx);
                const float alpha = __builtin_amdgcn_exp2f(mrun[qt] - mnew);
                mrun[qt] = mnew;
                lrun[qt] = lrun[qt] * alpha;
#pragma unroll
                for (int dt = 0; dt < 8; ++dt) O[qt][dt] = O[qt][dt] * alpha;
            }
            const float mnew = mrun[qt];
            float ls = 0.f;
#pragma unroll
            for (int kt = 0; kt < 4; ++kt)
#pragma unroll
                for (int j = 0; j < 4; ++j) { const float p = __builtin_amdgcn_exp2f(s[kt][qt][j] - mnew); s[kt][qt][j] = p; ls += p; }
            lrun[qt] += ls;
#pragma unroll
            for (int kk = 0; kk < 2; ++kk) {
                u32x4 w; w.x = pg8::cvt_pk_bf16(s[2 * kk][qt][0], s[2 * kk][qt][1]); w.y = pg8::cvt_pk_bf16(s[2 * kk][qt][2], s[2 * kk][qt][3]);
                w.z = pg8::cvt_pk_bf16(s[2 * kk + 1][qt][0], s[2 * kk + 1][qt][1]); w.w = pg8::cvt_pk_bf16(s[2 * kk + 1][qt][2], s[2 * kk + 1][qt][3]);
                pb[qt][kk] = __builtin_bit_cast(bf16x8, w);
            }
        }
        if (!grpB) AT_PV(Kt + 8704);
        }
        rb = rbn;
        __syncthreads();
    }
#undef AT_PV
#undef AT_LOAD
#undef AT_STORE
    float inv[2];
#pragma unroll
    for (int qt = 0; qt < 2; ++qt) { float l = lrun[qt]; l += __shfl_xor(l, 16); l += __shfl_xor(l, 32); inv[qt] = 1.0f / l; }
    __syncthreads();
    if (sm == 1) {
#pragma unroll
        for (int qt = 0; qt < 2; ++qt)
#pragma unroll
            for (int dt = 0; dt < 8; ++dt)
#pragma unroll
                for (int j = 0; j < 4; ++j) XO[(qg * 64 + (qt * 8 + dt) * 4 + j) * 64 + lane] = O[qt][dt][j] * inv[qt];
    }
    __syncthreads();
    if (sm == 0) {
#pragma unroll
        for (int qt = 0; qt < 2; ++qt) {
            float ss = 0.f;
#pragma unroll
            for (int dt = 0; dt < 8; ++dt)
#pragma unroll
                for (int j = 0; j < 4; ++j) { const float o = O[qt][dt][j] * inv[qt] - lam * XO[(qg * 64 + (qt * 8 + dt) * 4 + j) * 64 + lane]; O[qt][dt][j] = o; ss += o * o; }
            ss += __shfl_xor(ss, 16); ss += __shfl_xor(ss, 32);
            const float r = (1.0f - LAM_INIT0) / sqrtf(ss * (1.0f / 128.0f) + RMS_EPS_F);
            bf16_t* rowp = CAT + (size_t)(qrow0 + qg * 32 + qt * 16 + fr) * 2048 + h * 128 + 4 * fq;
#pragma unroll
            for (int dt = 0; dt < 8; ++dt) {
                const f32x4 w4 = *(const f32x4*)(subln + dt * 16 + 4 * fq);
                u32x2 w; w.x = pk2(O[qt][dt][0] * r * w4[0], O[qt][dt][1] * r * w4[1]); w.y = pk2(O[qt][dt][2] * r * w4[2], O[qt][dt][3] * r * w4[3]);
                *(u32x2*)(rowp + dt * 16) = w;
            }
        }
    }
}

constexpr int SC_RAWQ = 0, SC_RAWLF = 16384, SC_RAWVT = 32768, SC_PREP = 63488, SC_PREP_SZ = 36864;
constexpr int SP_QI = 0, SP_QR = 8704, SP_KR = 17408, SP_KET = 26112, SP_DEC = 36352;
#define chunk_row0(ci) ((ci) < 8 ? (MLAT + b * CTXL + 32 * (dir ? 7 - (ci) : (ci))) : (b * SEQ + 32 * (dir ? 63 - ((ci) - 8) : ((ci) - 8))))
template <int G_, int DIR_>
__device__ __forceinline__ void scan_elem_t(unsigned char* lds, int ci, int k) {
    const int cur = ci & 1; const bool need_out = ci >= 8;
    const bf16_t* rawq = (const bf16_t*)(lds + SC_RAWQ + cur * 8192) + k;
    const _Float16* rawlf = (const _Float16*)(lds + SC_RAWLF + cur * 8192) + k;
    unsigned char* pb = lds + SC_PREP + cur * SC_PREP_SZ;
    bf16_t* QI = (bf16_t*)(pb + SP_QI) + k; bf16_t* QR = (bf16_t*)(pb + SP_QR) + k; bf16_t* KR = (bf16_t*)(pb + SP_KR) + k; bf16_t* KET = (bf16_t*)(pb + SP_KET); float* DEC = (float*)(pb + SP_DEC);
    float run = 0.f, ref = 0.f, cums[8], lfv[8];
#pragma unroll
    for (int p = 0; p < 32; ++p) {
        const int i = DIR_ ? 31 - p : p;
        const float x = (float)rawlf[i * 128];
        run += x;
        if ((p >> 3) == G_) { cums[p & 7] = run; lfv[p & 7] = x; }
        if (p == 15) ref = run;
    }
    const float tot = run;
    const float E1 = __expf(fminf(-ref, 80.f)), E2 = __expf(fminf(ref - tot, 80.f));
    float ket[8], ec[8];
#pragma unroll
    for (int e = 0; e < 8; ++e) { ket[e] = (1.0f - __expf(lfv[e])) * __expf(tot - cums[e]); ec[e] = __expf(cums[e]); }
    if (need_out) {
#pragma unroll
        for (int e = 0; e < 8; e += 2) {
            const int p0 = 8 * G_ + e, i0 = DIR_ ? 31 - p0 : p0, i1 = DIR_ ? i0 - 1 : i0 + 1;
            const float qa = bf2f(rawq[i0 * 128]) * ec[e], qb = bf2f(rawq[i1 * 128]) * ec[e + 1];
            const unsigned wi = pg8::cvt_pk_bf16(qa, qb), wr_ = pg8::cvt_pk_bf16(qa * E1, qb * E1), wk = pg8::cvt_pk_bf16(ket[e] * E2, ket[e + 1] * E2);
            QI[i0 * 136] = (bf16_t)(wi & 0xffffu); QI[i1 * 136] = (bf16_t)(wi >> 16);
            QR[i0 * 136] = (bf16_t)(wr_ & 0xffffu); QR[i1 * 136] = (bf16_t)(wr_ >> 16);
            KR[i0 * 136] = (bf16_t)(wk & 0xffffu); KR[i1 * 136] = (bf16_t)(wk >> 16);
        }
    }
    u32x4 wv;
    if (DIR_) { wv.x = pg8::cvt_pk_bf16(ket[7], ket[6]); wv.y = pg8::cvt_pk_bf16(ket[5], ket[4]); wv.z = pg8::cvt_pk_bf16(ket[3], ket[2]); wv.w = pg8::cvt_pk_bf16(ket[1], ket[0]); }
    else      { wv.x = pg8::cvt_pk_bf16(ket[0], ket[1]); wv.y = pg8::cvt_pk_bf16(ket[2], ket[3]); wv.z = pg8::cvt_pk_bf16(ket[4], ket[5]); wv.w = pg8::cvt_pk_bf16(ket[6], ket[7]); }
    const int i0 = DIR_ ? 24 - 8 * G_ : 8 * G_;
    *(u32x4*)(KET + k * 40 + i0) = wv;
    if (G_ == 0) DEC[k] = __expf(tot);
}
__device__ __forceinline__ void scan_elem(unsigned char* lds, int ci, int dir, int k, int g) {
    const int sel = __builtin_amdgcn_readfirstlane(g * 2 + dir);
    switch (sel) {
        case 0: scan_elem_t<0, 0>(lds, ci, k); break;
        case 1: scan_elem_t<0, 1>(lds, ci, k); break;
        case 2: scan_elem_t<1, 0>(lds, ci, k); break;
        case 3: scan_elem_t<1, 1>(lds, ci, k); break;
        case 4: scan_elem_t<2, 0>(lds, ci, k); break;
        case 5: scan_elem_t<2, 1>(lds, ci, k); break;
        case 6: scan_elem_t<3, 0>(lds, ci, k); break;
        default: scan_elem_t<3, 1>(lds, ci, k); break;
    }
}
__device__ __forceinline__ void scan_mfma(unsigned char* lds, f32x4 (&S)[8], int ci, int vt3, int dir, int r0, bf16_t* Od, int h, int w, int fr, int fq) {
    const int cur = ci & 1; const bool need_out = ci >= 8;
    const bf16_t* rawvt = (const bf16_t*)(lds + SC_RAWVT + vt3 * 10240);
    unsigned char* pb = lds + SC_PREP + cur * SC_PREP_SZ;
    const bf16_t* QI = (const bf16_t*)(pb + SP_QI); const bf16_t* QR = (const bf16_t*)(pb + SP_QR); const bf16_t* KR = (const bf16_t*)(pb + SP_KR); const bf16_t* KET = (const bf16_t*)(pb + SP_KET); const float* DEC = (const float*)(pb + SP_DEC);
    if (need_out) {
        f32x4 sc[2][2];
#pragma unroll
        for (int st = 0; st < 2; ++st)
#pragma unroll
            for (int tt = 0; tt < 2; ++tt) {
                f32x4 z = {0.f, 0.f, 0.f, 0.f};
#pragma unroll
                for (int kk = 0; kk < 4; ++kk) {
                    const bf16x8 a = *(const bf16x8*)(KR + (st * 16 + fr) * 136 + kk * 32 + fq * 8);
                    const bf16x8 bq = *(const bf16x8*)(QR + (tt * 16 + fr) * 136 + kk * 32 + fq * 8);
                    z = __builtin_amdgcn_mfma_f32_16x16x32_bf16(a, bq, z, 0, 0, 0);
                }
#pragma unroll
                for (int j = 0; j < 4; ++j) { const int s_ = st * 16 + 4 * fq + j, t_ = tt * 16 + fr; const bool ok = dir ? (s_ >= t_) : (s_ <= t_); z[j] = ok ? z[j] : 0.f; }
                sc[st][tt] = z;
            }
        bf16x8 Sb[4];
#pragma unroll
        for (int kk = 0; kk < 4; ++kk) {
            u32x4 wv; wv.x = pg8::cvt_pk_bf16(S[2 * kk][0], S[2 * kk][1]); wv.y = pg8::cvt_pk_bf16(S[2 * kk][2], S[2 * kk][3]);
            wv.z = pg8::cvt_pk_bf16(S[2 * kk + 1][0], S[2 * kk + 1][1]); wv.w = pg8::cvt_pk_bf16(S[2 * kk + 1][2], S[2 * kk + 1][3]);
            Sb[kk] = __builtin_bit_cast(bf16x8, wv);
        }
        const u32x2 vlo = *(const u32x2*)(rawvt + (16 * w + fr) * 40 + 4 * fq);
        const u32x2 vhi = *(const u32x2*)(rawvt + (16 * w + fr) * 40 + 16 + 4 * fq);
        u32x4 vw; vw.x = vlo.x; vw.y = vlo.y; vw.z = vhi.x; vw.w = vhi.y;
        const bf16x8 bv = __builtin_bit_cast(bf16x8, vw);
#pragma unroll
        for (int tt = 0; tt < 2; ++tt) {
            u32x4 pw; pw.x = pg8::cvt_pk_bf16(sc[0][tt][0], sc[0][tt][1]); pw.y = pg8::cvt_pk_bf16(sc[0][tt][2], sc[0][tt][3]);
            pw.z = pg8::cvt_pk_bf16(sc[1][tt][0], sc[1][tt][1]); pw.w = pg8::cvt_pk_bf16(sc[1][tt][2], sc[1][tt][3]);
            f32x4 o = {0.f, 0.f, 0.f, 0.f}, o2 = {0.f, 0.f, 0.f, 0.f};
            o = __builtin_amdgcn_mfma_f32_16x16x32_bf16(__builtin_bit_cast(bf16x8, pw), bv, o, 0, 0, 0);
#pragma unroll
            for (int kk = 0; kk < 4; ++kk) {
                const u32x2 alo = *(const u32x2*)(QI + (tt * 16 + fr) * 136 + kk * 32 + 4 * fq);
                const u32x2 ahi = *(const u32x2*)(QI + (tt * 16 + fr) * 136 + kk * 32 + 16 + 4 * fq);
                u32x4 aw; aw.x = alo.x; aw.y = alo.y; aw.z = ahi.x; aw.w = ahi.y;
                if (kk & 1) o2 = __builtin_amdgcn_mfma_f32_16x16x32_bf16(__builtin_bit_cast(bf16x8, aw), Sb[kk], o2, 0, 0, 0);
                else        o  = __builtin_amdgcn_mfma_f32_16x16x32_bf16(__builtin_bit_cast(bf16x8, aw), Sb[kk], o, 0, 0, 0);
            }
            o = o + o2;
#pragma unroll
            for (int j = 0; j < 4; ++j) Od[(size_t)(r0 + tt * 16 + 4 * fq + j) * DM + h * 128 + 16 * w + fr] = (bf16_t)f2bf(o[j]);
        }
    }
    const bf16x8 bvt = *(const bf16x8*)(rawvt + (16 * w + fr) * 40 + fq * 8);
#pragma unroll
    for (int i = 0; i < 8; ++i) {
        const f32x4 dec = *(const f32x4*)(DEC + 16 * i + 4 * fq);
        const bf16x8 a = *(const bf16x8*)(KET + (16 * i + fr) * 40 + fq * 8);
        S[i] = __builtin_amdgcn_mfma_f32_16x16x32_bf16(a, bvt, S[i] * dec, 0, 0, 0);
    }
}
__device__ __forceinline__ void scan_chain(unsigned char* lds, const bf16_t* Q1, const _Float16* LFd, const bf16_t* VT1, bf16_t* Od, int b, int h, int dir) {
    int tid_ = threadIdx.x; asm volatile("" : "+v"(tid_)); const int tid = tid_, lane = tid & 63, w = tid >> 6, fr = lane & 15, fq = lane >> 4;
    const int k = tid & 127, g = tid >> 7;
    f32x4 S[8];
#pragma unroll
    for (int i = 0; i < 8; ++i) S[i] = (f32x4){0.f, 0.f, 0.f, 0.f};
    u32x4 rq, rl, rv;
#define SC_LOAD(ci_) do { const int r_ = chunk_row0(ci_); \
        rq = *(const u32x4*)(Q1 + (size_t)(r_ + (tid >> 4)) * DM + h * 128 + (tid & 15) * 8); \
        rl = *(const u32x4*)(LFd + (size_t)(r_ + (tid >> 4)) * DM + h * 128 + (tid & 15) * 8); \
        rv = *(const u32x4*)(VT1 + (size_t)(h * 128 + (tid >> 2)) * MTOT + r_ + (tid & 3) * 8); } while (0)
#define SC_STORE(par_, v3_) do { \
        *(u32x4*)(lds + SC_RAWQ + (par_) * 8192 + (tid >> 4) * 256 + (tid & 15) * 16) = rq; \
        *(u32x4*)(lds + SC_RAWLF + (par_) * 8192 + (tid >> 4) * 256 + (tid & 15) * 16) = rl; \
        *(u32x4*)(lds + SC_RAWVT + (v3_) * 10240 + (tid >> 2) * 80 + (tid & 3) * 16) = rv; } while (0)
    SC_LOAD(0); SC_STORE(0, 0);
    SC_LOAD(1); SC_STORE(1, 1);
    __syncthreads();
    scan_elem(lds, 0, dir, k, g);
    __syncthreads();
    int v3 = 0;
    for (int ci = 0; ci < 72; ++ci) {
        const int r0 = chunk_row0(ci);
        if (ci + 2 < 72) SC_LOAD(ci + 2);
        scan_mfma(lds, S, ci, v3, dir, r0, Od, h, w, fr, fq);
        if (ci + 1 < 72) scan_elem(lds, ci + 1, dir, k, g);
        const int v3n = v3 == 0 ? 2 : v3 - 1;
        if (ci + 2 < 72) SC_STORE(ci & 1, v3n);
        v3 = v3 == 2 ? 0 : v3 + 1;
        __syncthreads();
    }
#undef SC_LOAD
#undef SC_STORE
}

#define LAS __attribute__((address_space(3)))
#define XB_TMO      128
#define XB_XCNT(j)  (256  + 64 * (j))
#define XB_XSUB(j)  (1280 + 64 * (j))
#define XB_XGEN(j)  (2304 + 64 * (j))
#define XB_TOP      3328
#define XB_TOPGEN   3392
#define XCD_BAR_WORDS 3456
#define XB_SPIN_CAP (1u << 18)

__device__ __forceinline__ unsigned xb_ld(unsigned* p)              { return __hip_atomic_load(p, __ATOMIC_RELAXED, __HIP_MEMORY_SCOPE_AGENT); }
__device__ __forceinline__ unsigned xb_add(unsigned* p, unsigned v) { return __hip_atomic_fetch_add(p, v, __ATOMIC_RELAXED, __HIP_MEMORY_SCOPE_AGENT); }
__device__ __forceinline__ unsigned xb_xcc_id() { return (unsigned)__builtin_amdgcn_s_getreg((3 << 11) | 20) & 0xFu; }
#define XB_SPIN(cond, bar) do { unsigned _sp = 0; while (cond) { __builtin_amdgcn_s_sleep(1); \
    if ((++_sp & 255u) == 0u) { if (xb_ld(&(bar)[XB_TMO])) break; if (_sp > XB_SPIN_CAP) { atomicAdd(&(bar)[XB_TMO], 1u); break; } } } } while (0)

struct XcdBarrier {
    unsigned* bar; unsigned x;
    volatile LAS unsigned* st;
};

__device__ __forceinline__ XcdBarrier xcd_barrier_post(unsigned* bar, volatile LAS unsigned* st) {
    XcdBarrier b; b.bar = bar; b.x = xb_xcc_id(); b.st = st;
    if (threadIdx.x == 0) (void)xb_add(&bar[XB_XCNT(b.x)], 1u);
    return b;
}
__device__ __forceinline__ void xcd_barrier_complete(unsigned* bar, unsigned x, unsigned& nloc, unsigned& nx) {
    const unsigned G = gridDim.x * gridDim.y * gridDim.z;
    unsigned sum, cnt, mine, sp = 0u;
    for (;;) {
        sum = 0u; cnt = 0u; mine = 0u;
#pragma unroll
        for (unsigned j = 0; j < 16; ++j) { const unsigned c = xb_ld(&bar[XB_XCNT(j)]); sum += c; cnt += (c > 0u) ? 1u : 0u; mine = (j == x) ? c : mine; }
        if (sum == G) break;
        __builtin_amdgcn_s_sleep(1);
        if ((++sp & 255u) == 0u) { if (xb_ld(&bar[XB_TMO])) break; if (sp > XB_SPIN_CAP) { atomicAdd(&bar[XB_TMO], 1u); break; } }
    }
    nloc = mine > 0u ? mine : 1u; nx = cnt > 0u ? cnt : 1u;
}

__device__ __forceinline__ void xcd_barrier(const XcdBarrier& b) {
    asm volatile("s_waitcnt vmcnt(0)" ::: "memory");
    __syncthreads();
    if (threadIdx.x == 0) {
        unsigned* bar = b.bar;
        __builtin_amdgcn_s_waitcnt(0);
        unsigned nloc = b.st[0], nx = b.st[1];
        if (nloc == 0u) { xcd_barrier_complete(bar, b.x, nloc, nx); b.st[0] = nloc; b.st[1] = nx; }
        const unsigned old = xb_add(&bar[XB_XSUB(b.x)], 1u);
        const unsigned gen = old / nloc;
        if (old + 1u == (gen + 1u) * nloc) {
            __builtin_amdgcn_fence(__ATOMIC_RELEASE, "agent");
            asm volatile("s_waitcnt vmcnt(0)" ::: "memory");
            const unsigned og = xb_add(&bar[XB_TOP], 1u);
            const unsigned tg = og / nx;
            if (og + 1u == (tg + 1u) * nx) xb_add(&bar[XB_TOPGEN], 1u);
            else XB_SPIN(xb_ld(&bar[XB_TOPGEN]) == tg, bar);
            __builtin_amdgcn_fence(__ATOMIC_ACQUIRE, "agent");
            xb_add(&bar[XB_XGEN(b.x)], 1u);
            asm volatile("s_waitcnt vmcnt(0)" ::: "memory");
        } else {
            XB_SPIN(xb_ld(&bar[XB_XGEN(b.x)]) == gen, bar);
            __builtin_amdgcn_fence(__ATOMIC_ACQUIRE, "agent");
            asm volatile("s_waitcnt vmcnt(0)" ::: "memory");
        }
    }
    __syncthreads();
}

__global__ void __launch_bounds__(512, 2) hybrid_fwd(Args args) {
    extern __shared__ __attribute__((aligned(16))) unsigned char lds[];
    cg::grid_group grid = cg::this_grid();
    const int tid = threadIdx.x, lane = tid & 63, wave = __builtin_amdgcn_readfirstlane(tid >> 6);
    const int G = gridDim.x, bid = blockIdx.x;
    const int gw = bid * 8 + wave, NGW = G * 8;
    unsigned char* ws = args.ws;
    PG8_LAS unsigned char* ldsg = (PG8_LAS unsigned char*)lds;

    const float* x = args.in[0]; const float* cvec = args.in[1]; const float* ctx = args.in[2]; const float* c_ctx = args.in[3];
    const float* mod_w = args.in[4]; const float* mod_b = args.in[5];
    const float* ln_mix_g = args.in[6]; const float* ln_mix_b = args.in[7]; const float* ln_ffn_g = args.in[8]; const float* ln_ffn_b = args.in[9];
    const float* even_w_in = args.in[10]; const float* even_w_out = args.in[11]; const float* diff_lambda = args.in[12]; const float* diff_subln = args.in[13];
    const float* hgrn_w_in = args.in[14]; const float* hgrn_w_out = args.in[15]; const float* hgrn_lb = args.in[16]; const float* hgrn_norm = args.in[17];
    const float* ffn_w_up = args.in[18]; const float* ffn_conv_w = args.in[19]; const float* ffn_conv_b = args.in[20]; const float* ffn_w_down = args.in[21];
    float* hlat = args.out;
    float* hctx = (float*)(ws + WS_HCTX);
    float* modv = (float*)(ws + WS_MODV);
    float* rope = (float*)(ws + WS_ROPE);
    bf16_t* U = (bf16_t*)(ws + WS_U);
    unsigned* ctl = (unsigned*)(ws + WS_CTL);
    if (tid < 64) ((volatile LAS unsigned*)((LAS unsigned char*)lds + LDS_MISC))[tid] = 0u;
    __syncthreads();
    const XcdBarrier xbar = xcd_barrier_post(ctl + 1024, (volatile LAS unsigned*)((LAS unsigned char*)lds + LDS_MISC + 32));
#define GRID_BAR() xcd_barrier(xbar)

    for (int rep = 0; rep < (PROBE == 3 ? 2 : 1); ++rep) {
        if (bid == 0) {
            for (int e = tid; e < 1024; e += 512) {
                const int pos = e >> 4, i = e & 15;
                const float inv = 1.0f / powf(10000.0f, (float)(2 * i) / 32.0f);
                const float ang = (float)pos * inv;
                rope[e] = cosf(ang); rope[1024 + e] = sinf(ang);
            }
        }
        {
            float* sl = (float*)lds;
            float* red = (float*)(lds + 81920);
            for (int e = tid; e < 9 * DM; e += 512) { const int r = e >> 11, kk = e & 2047; const float v = r < 8 ? cvec[r * DM + kk] : c_ctx[kk]; sl[e] = silu_f(v); }
            __syncthreads();
            const int cg4 = tid & 7, kg = tid >> 3;
            float* red2 = (float*)(lds + 81920);
            for (int it = bid; it < 768; it += G) {
                const int l = it / 384, n0 = (it % 384) * 32;
                const float* wp = mod_w + (size_t)l * DM * NMOD + (size_t)(kg * 32) * NMOD + n0 + cg4 * 4;
                f32x4 a[9];
#pragma unroll
                for (int r = 0; r < 9; ++r) a[r] = (f32x4){0.f, 0.f, 0.f, 0.f};
#pragma unroll 8
                for (int kk = 0; kk < 32; ++kk) {
                    const f32x4 wv = *(const f32x4*)(wp + (size_t)kk * NMOD);
#pragma unroll
                    for (int r = 0; r < 9; ++r) a[r] += wv * sl[r * DM + kg * 32 + kk];
                }
#pragma unroll
                for (int r = 0; r < 9; ++r)
#pragma unroll
                    for (int j = 0; j < 4; ++j) { float t = a[r][j]; t += __shfl_xor(t, 8); t += __shfl_xor(t, 16); t += __shfl_xor(t, 32); a[r][j] = t; }
                if (lane < 8) {
#pragma unroll
                    for (int r = 0; r < 9; ++r) *(f32x4*)(red2 + (wave * 9 + r) * 32 + lane * 4) = a[r];
                }
                __syncthreads();
                if (tid < 288) {
                    const int r = tid >> 5, c2 = tid & 31; float s = 0.f;
#pragma unroll
                    for (int q2 = 0; q2 < 8; ++q2) s += red2[(q2 * 9 + r) * 32 + c2];
                    modv[(size_t)(l * 9 + r) * NMOD + n0 + c2] = s + mod_b[l * NMOD + n0 + c2];
                }
                __syncthreads();
            }
        }
        {
            bf16_t* D2 = (bf16_t*)(ws + WS_D2);
            for (size_t e = (size_t)bid * 512 + tid; e < (size_t)2048 * 512; e += (size_t)G * 512) {
                const int kq = (int)(e >> 9), n0 = (int)(e & 511) * 8;
                float v[8];
#pragma unroll
                for (int j = 0; j < 8; ++j) { const int n = n0 + j; const int mm = (kq * (n & 2047)) & 2047; const float a = (float)mm * (1.0f / 1024.0f); v[j] = n < 2048 ? cospif(a) : -sinpif(a); }
                u32x4 w; w.x = pk2(v[0], v[1]); w.y = pk2(v[2], v[3]); w.z = pk2(v[4], v[5]); w.w = pk2(v[6], v[7]);
                *(u32x4*)(D2 + (size_t)kq * 4096 + n0) = w;
            }
            bf16_t* D2C = (bf16_t*)(ws + WS_D2C);
            for (int e = bid * 512 + tid; e < 256 * 64; e += G * 512) {
                const int kq = e >> 6, n0 = (e & 63) * 8;
                float v[8];
#pragma unroll
                for (int j = 0; j < 8; ++j) { const int n = n0 + j; const int mm = (kq * (n & 255)) & 255; const float a = (float)mm * (1.0f / 128.0f); v[j] = n < 256 ? cospif(a) : -sinpif(a); }
                u32x4 w; w.x = pk2(v[0], v[1]); w.y = pk2(v[2], v[3]); w.z = pk2(v[4], v[5]); w.w = pk2(v[6], v[7]);
                *(u32x4*)(D2C + (size_t)kq * 512 + n0) = w;
            }
        }
        __syncthreads();
        {
            float* wt = (float*)lds;
            float* tab = (float*)(lds + 64 * 129 * 4);
            bf16_t* W0VF = (bf16_t*)(ws + WS_W0VF);
            for (int it = bid; it < 128; it += G) {
                const int kb = it >> 2, gq = it & 3;
                __syncthreads();
                if (tid < 128) tab[tid] = cospif((float)tid * (1.0f / 64.0f));
                for (int e = tid; e < 64 * 128; e += 512) { const int kk = e >> 7, c = e & 127; wt[kk * 129 + c] = even_w_in[(size_t)(kb * 64 + kk) * 5120 + 4608 + gq * 128 + c]; }
                __syncthreads();
                const int kk = tid & 63, mg = tid >> 6;
                for (int mi = 0; mi < 16; ++mi) {
                    const int mm = mg * 16 + mi;
                    float sa = 0.f, sb = 0.f;
#pragma unroll 8
                    for (int c = 0; c < 128; ++c) { const float wv = wt[kk * 129 + c]; const int ph = (c * mm) & 127; sa += wv * tab[ph]; sb += wv * tab[(ph + 96) & 127]; }
                    W0VF[(size_t)(1536 + gq * 128 + mm) * DM + kb * 64 + kk] = (bf16_t)f2bf(sa);
                    W0VF[(size_t)(2048 + gq * 128 + mm) * DM + kb * 64 + kk] = (bf16_t)f2bf(sb);
                }
            }
        }
        __syncthreads();
        {
            float* scr = (float*)(lds + wave * 16384);
            int base = 0;
#define RUNJOB(W_, ldw_, K_, ncols_, col0_, WT_, mode_, drow_) do { const TJob jb{W_, ldw_, K_, ncols_, col0_, WT_, mode_}; const int ni = tjob_items(jb); \
                const int first = ((gw - base) % NGW + NGW) % NGW; for (int it = first; it < ni; it += NGW) tjob_run(jb, drow_, it, scr, lane); base += ni; } while (0)
            RUNJOB(even_w_in, 5120, DM, 3072, 0, (bf16_t*)(ws + WS_W0QK), 0, 0);
            RUNJOB(even_w_in, 5120, DM, 1536, 3072, (bf16_t*)(ws + WS_W0VF), 0, 0);
            RUNJOB(even_w_out, DM, DM, DM, 0, (bf16_t*)(ws + WS_W0OUT), 0, 0);
            RUNJOB(hgrn_w_in, 10240, DM, 6144, 0, (bf16_t*)(ws + WS_W1A), 0, 0);
            RUNJOB(hgrn_w_in, 10240, DM, DM, 6144, (bf16_t*)(ws + WS_W1V), 0, 0);
            RUNJOB(hgrn_w_in, 10240, DM, DM, 8192, (bf16_t*)(ws + WS_W1A), 0, 6144);
            RUNJOB(hgrn_w_out, DM, DM, DM, 0, (bf16_t*)(ws + WS_W1OUT), 0, 0);
            RUNJOB(ffn_w_up, 2 * DFF, DM, 2 * DFF, 0, (bf16_t*)(ws + WS_WUP), 1, 0);
            RUNJOB(ffn_w_up + (size_t)DM * 2 * DFF, 2 * DFF, DM, 2 * DFF, 0, (bf16_t*)(ws + WS_WUP + 43 * MiB), 1, 0);
            RUNJOB(ffn_w_down, DM, DFF, DM, 0, (bf16_t*)(ws + WS_WDN), 0, 0);
            RUNJOB(ffn_w_down + (size_t)DFF * DM, DM, DFF, DM, 0, (bf16_t*)(ws + WS_WDN + 21 * MiB + 512 * 1024), 0, 0);
#undef RUNJOB
        }
    }
    grid.sync();

    for (int r = gw; r < MTOT; r += NGW) {
        const bool lat = r < MLAT;
        const float* zr = lat ? x + (size_t)r * DM : ctx + (size_t)(r - MLAT) * DM;
        const float* mrow = modv + (size_t)(0 * 9 + (lat ? (r >> 11) : 8)) * NMOD;
        row_op(zr, nullptr, nullptr, nullptr, false, mrow + 0 * DM, mrow + 1 * DM, U + (size_t)r * DM, lane);
    }
    GRID_BAR();

    {
        pg8::Gemm g1{U, (const bf16_t*)(ws + WS_W0QK), MTOT, 3072, DM}; pg8::StaticOrder S1; S1.init(MTOT, 3072, G, bid);
        EpiQK E1{(bf16_t*)(ws + R_QK), rope};
        pg8::gemm_phase<EpiQK, pg8::StaticOrder, GEMM_ALIGN, GEMM_SP2>(ldsg, g1, S1, E1);
        pg8::Gemm g2{(const bf16_t*)(ws + WS_W0VF), U, 2560, MTOT, DM}; pg8::StaticOrder S2; S2.init(2560, MTOT, G, (bid + 128) % G);
        EpiT E2{(bf16_t*)(ws + R_VT0), (bf16_t*)(ws + R_FTL), (bf16_t*)(ws + R_FTC), 0};
        pg8::gemm_phase<EpiT, pg8::StaticOrder, GEMM_ALIGN, GEMM_SP2>(ldsg, g2, S2, E2);
    }
    GRID_BAR();

    {
        pg8::Gemm gf{(const bf16_t*)(ws + WS_D2), (const bf16_t*)(ws + R_FTL), 2048, 4096, 4096}; pg8::StaticOrder Sf; Sf.init(2048, 4096, G, bid);
        EpiFour Ef{(bf16_t*)(ws + R_CAT), 0, SEQ, 1.0f / 512.0f};
        pg8::gemm_phase<EpiFour, pg8::StaticOrder, GEMM_ALIGN, GEMM_SP2>(ldsg, gf, Sf, Ef);
        pg8::Gemm gc{(const bf16_t*)(ws + WS_D2C), (const bf16_t*)(ws + R_FTC), 256, 4096, 512}; pg8::StaticOrder Sc; Sc.init(256, 4096, G, (bid + G - 128) % G);
        EpiFour Ec{(bf16_t*)(ws + R_CAT), MLAT, CTXL, 0.005524271728019903f};
        pg8::gemm_phase<EpiFour, pg8::StaticOrder, GEMM_ALIGN, GEMM_SP2>(ldsg, gc, Sc, Ec);
        float lam;
        {
            const float d01 = wave_sum(diff_lambda[lane] * diff_lambda[64 + lane]);
            const float d23 = wave_sum(diff_lambda[128 + lane] * diff_lambda[192 + lane]);
            lam = expf(d01) - expf(d23) + LAM_INIT0;
        }
        volatile int* qslot = (volatile int*)(lds + LDS_MISC);
        const int xq0 = (int)(xbar.x & 7u);
        for (int dq = 0; dq < 8; ++dq) {
        const int xq = (xq0 + dq) & 7;
        for (;;) {
            __syncthreads();
            if (tid == 0) *qslot = (int)atomicAdd(ctl + 64 + 64 * xq, 1u);
            __syncthreads();
            const int idx = *qslot;
            if (idx >= 216) break;
            int unit;
            if (idx < 192) unit = (xq * 12 + (idx >> 4)) * 16 + (idx & 15);
            else unit = 1536 + (xq * 12 + ((idx - 192) >> 1)) * 2 + ((idx - 192) & 1);
            attn_unit(lds, (const bf16_t*)(ws + R_QK), (const bf16_t*)(ws + R_VT0), (bf16_t*)(ws + R_CAT), diff_subln, lam, unit);
        }
        }
    }
    GRID_BAR();

    {
        pg8::Gemm g{(const bf16_t*)(ws + R_CAT), (const bf16_t*)(ws + WS_W0OUT), MTOT, DM, DM}; pg8::StaticOrder S; S.init(MTOT, DM, G, bid);
        EpiResid E{(bf16_t*)(ws + R_MB), modv + 0 * 9 * NMOD + 2 * DM};
        pg8::gemm_phase<EpiResid, pg8::StaticOrder, GEMM_ALIGN, GEMM_SP2>(ldsg, g, S, E);
    }
    GRID_BAR();

#define HROW(r) ((r) < MLAT ? hlat + (size_t)(r) * DM : hctx + (size_t)((r) - MLAT) * DM)
    for (int r = gw; r < MTOT; r += NGW) {
        const float* mrow = modv + (size_t)(0 * 9 + (r < MLAT ? (r >> 11) : 8)) * NMOD;
        row_op(r < MLAT ? x + (size_t)r * DM : ctx + (size_t)(r - MLAT) * DM, HROW(r), ln_mix_g, ln_mix_b, true, mrow + 3 * DM, mrow + 4 * DM, U + (size_t)r * DM, lane, (const bf16_t*)(ws + R_MB) + (size_t)r * DM);
    }
    GRID_BAR();

#define FFN_PHASES(L, MROWS) \
    { \
        pg8::Gemm g{U, (const bf16_t*)(ws + WS_WUP + (size_t)(L) * 43 * MiB), (MROWS), 2 * DFF, DM}; pg8::StaticOrder S; S.init((MROWS), 2 * DFF, G, bid); \
        EpiUpFused E{(bf16_t*)(ws + R_A1), (float*)(ws + R_EDGE), (float*)(ws + R_EDGE + 4 * MiB), (float*)(ws + R_EDGE + 8 * MiB), ffn_conv_w + (size_t)(L) * 3 * DFF, ffn_conv_b + (size_t)(L) * DFF, (float*)(lds + LDS_MISC + 1024)}; \
        pg8::gemm_phase<EpiUpFused, pg8::StaticOrder, true, GEMM_SP2>(ldsg, g, S, E); \
    } \
    GRID_BAR(); \
    { \
        bf16_t* HID = (bf16_t*)(ws + R_A1); const float* EA = (const float*)(ws + R_EDGE); const float* EP = (const float*)(ws + R_EDGE + 4 * MiB); const float* EV = (const float*)(ws + R_EDGE + 8 * MiB); \
        const float* cw = ffn_conv_w + (size_t)(L) * 3 * DFF; \
        const int nedge = ((MROWS) / 256) * 2 * DFF; \
        for (int it = bid * 512 + tid; it < nedge; it += G * 512) { \
            const int c = it % DFF, pe = it / DFF, pm = pe >> 1, e = pe & 1; \
            const bool lat = pm < 64; \
            float nb = 0.f; \
            if (e == 0) { if (lat && (pm & 7) != 0) nb = EA[(size_t)((pm - 1) * 2 + 1) * DFF + c]; } \
            else { if (lat && (pm & 7) != 7) nb = EA[(size_t)((pm + 1) * 2 + 0) * DFF + c]; } \
            const float cv = EP[(size_t)pe * DFF + c] + nb * cw[(e ? 2 * DFF : 0) + c]; \
            HID[(size_t)(pm * 256 + (e ? 255 : 0)) * DFF + c] = (bf16_t)f2bf(gelu_f(cv) * EV[(size_t)pe * DFF + c]); \
        } \
    } \
    GRID_BAR(); \
    { \
        pg8::Gemm g{(const bf16_t*)(ws + R_A1), (const bf16_t*)(ws + WS_WDN + (size_t)(L) * (21 * MiB + 512 * 1024)), (MROWS), DM, DFF}; pg8::StaticOrder S; S.init((MROWS), DM, G, bid); \
        EpiResid E{(bf16_t*)(ws + R_MB), modv + (size_t)(L) * 9 * NMOD + 5 * DM}; \
        pg8::gemm_phase<EpiResid, pg8::StaticOrder, GEMM_ALIGN, GEMM_SP2>(ldsg, g, S, E); \
    } \
    GRID_BAR();

    FFN_PHASES(0, MTOT)

    for (int r = gw; r < MTOT; r += NGW) {
        const float* mrow = modv + (size_t)(1 * 9 + (r < MLAT ? (r >> 11) : 8)) * NMOD;
        row_op(HROW(r), HROW(r), ln_ffn_g, ln_ffn_b, true, mrow + 0 * DM, mrow + 1 * DM, U + (size_t)r * DM, lane, (const bf16_t*)(ws + R_MB) + (size_t)r * DM);
    }
    GRID_BAR();

    {
        pg8::Gemm g1{U, (const bf16_t*)(ws + WS_W1A), MLAT, 8192, DM}; pg8::StaticOrder S1; S1.init(MLAT, 8192, G, bid);
        EpiH1 E1{(bf16_t*)(ws + R_Q1), (_Float16*)(ws + R_LF), (bf16_t*)(ws + R_G1), hgrn_lb, 0, 0};
        pg8::gemm_phase<EpiH1, pg8::StaticOrder, GEMM_ALIGN, GEMM_SP2>(ldsg, g1, S1, E1);
        pg8::Gemm g1c{U + (size_t)MLAT * DM, (const bf16_t*)(ws + WS_W1A) + (size_t)2048 * DM, MCTX, 4096, DM}; pg8::StaticOrder S1c; S1c.init(MCTX, 4096, G, bid);
        EpiH1 E1c{(bf16_t*)(ws + R_Q1), (_Float16*)(ws + R_LF), (bf16_t*)(ws + R_G1), hgrn_lb, MLAT, 8};
        pg8::gemm_phase<EpiH1, pg8::StaticOrder, GEMM_ALIGN, GEMM_SP2>(ldsg, g1c, S1c, E1c);
        pg8::Gemm g2{(const bf16_t*)(ws + WS_W1V), U, 2048, MTOT, DM}; pg8::StaticOrder S2; S2.init(2048, MTOT, G, (bid + 128) % G);
        EpiT E2{(bf16_t*)(ws + R_VT1), nullptr, nullptr, 1};
        pg8::gemm_phase<EpiT, pg8::StaticOrder, GEMM_ALIGN, GEMM_SP2>(ldsg, g2, S2, E2);
    }
    GRID_BAR();

    for (int rep = 0; rep < (PROBE == 2 ? 2 : 1); ++rep)
    for (int chain = bid; chain < 256; chain += G) {
        const int dir = chain & 1, bh = chain >> 1, b = bh >> 4, h = bh & 15;
        __syncthreads();
        scan_chain(lds, (const bf16_t*)(ws + R_Q1), (const _Float16*)(ws + R_LF) + (size_t)dir * MTOT * DM, (const bf16_t*)(ws + R_VT1),
                   dir ? (bf16_t*)(ws + R_OB) : U, b, h, dir);
    }
    GRID_BAR();

    {
        const bf16_t* OF = U; const bf16_t* OB = (const bf16_t*)(ws + R_OB); const bf16_t* G1 = (const bf16_t*)(ws + R_G1); bf16_t* Y = (bf16_t*)(ws + R_Q1);
        for (int r = gw; r < MLAT; r += NGW) {
            const size_t off = (size_t)r * DM + lane * 32;
            float o[32]; float ss = 0.f;
#pragma unroll
            for (int q4 = 0; q4 < 4; ++q4) {
                const u32x4 a = *(const u32x4*)(OF + off + q4 * 8), bq = *(const u32x4*)(OB + off + q4 * 8);
#pragma unroll
                for (int e = 0; e < 4; ++e) {
                    const float lo = bf2f((unsigned short)(a[e] & 0xffffu)) + bf2f((unsigned short)(bq[e] & 0xffffu));
                    const float hi = bf2f((unsigned short)(a[e] >> 16)) + bf2f((unsigned short)(bq[e] >> 16));
                    o[q4 * 8 + 2 * e] = lo; o[q4 * 8 + 2 * e + 1] = hi; ss += lo * lo + hi * hi;
                }
            }
            ss += __shfl_xor(ss, 1); ss += __shfl_xor(ss, 2);
            const float rs = 1.0f / sqrtf(ss * (1.0f / 128.0f) + RMS_EPS_F);
            const int d0 = (lane & 3) * 32;
#pragma unroll
            for (int q4 = 0; q4 < 4; ++q4) {
                const u32x4 gg = *(const u32x4*)(G1 + off + q4 * 8);
                u32x4 ow;
#pragma unroll
                for (int e = 0; e < 4; ++e) {
                    const float lo = o[q4 * 8 + 2 * e] * rs * hgrn_norm[d0 + q4 * 8 + 2 * e] * bf2f((unsigned short)(gg[e] & 0xffffu));
                    const float hi = o[q4 * 8 + 2 * e + 1] * rs * hgrn_norm[d0 + q4 * 8 + 2 * e + 1] * bf2f((unsigned short)(gg[e] >> 16));
                    ow[e] = pk2(lo, hi);
                }
                *(u32x4*)(Y + off + q4 * 8) = ow;
            }
        }
    }
    GRID_BAR();

    {
        pg8::Gemm g{(const bf16_t*)(ws + R_Q1), (const bf16_t*)(ws + WS_W1OUT), MLAT, DM, DM}; pg8::StaticOrder S; S.init(MLAT, DM, G, bid);
        EpiResid E{(bf16_t*)(ws + R_MB), modv + (size_t)1 * 9 * NMOD + 2 * DM};
        pg8::gemm_phase<EpiResid, pg8::StaticOrder, GEMM_ALIGN, GEMM_SP2>(ldsg, g, S, E);
    }
    GRID_BAR();

    for (int r = gw; r < MLAT; r += NGW) {
        const float* mrow = modv + (size_t)(1 * 9 + (r >> 11)) * NMOD;
        row_op(HROW(r), HROW(r), ln_mix_g + DM, ln_mix_b + DM, true, mrow + 3 * DM, mrow + 4 * DM, U + (size_t)r * DM, lane, (const bf16_t*)(ws + R_MB) + (size_t)r * DM);
    }
    GRID_BAR();

    FFN_PHASES(1, MLAT)

    for (int r = gw; r < MLAT; r += NGW)
        row_op(HROW(r), HROW(r), ln_ffn_g + DM, ln_ffn_b + DM, true, nullptr, nullptr, nullptr, lane, (const bf16_t*)(ws + R_MB) + (size_t)r * DM);
}

extern "C" void kernel_launch(void* const* d_in, const int* in_sizes, int n_in, void* d_out, int out_size, void* d_ws, size_t ws_size, hipStream_t stream) {
    static int grid = 0;
    if (grid == 0) {
        if (n_in != 22 || ws_size < WS_END) { fprintf(stderr, "kernel_launch: unexpected n_in %d / ws_size %zu\n", n_in, ws_size); grid = -1; return; }
        int dev = 0, cus = 0, per_cu = 0;
        (void)hipGetDevice(&dev);
        (void)hipDeviceGetAttribute(&cus, hipDeviceAttributeMultiprocessorCount, dev);
        if (hipFuncSetAttribute((const void*)hybrid_fwd, hipFuncAttributeMaxDynamicSharedMemorySize, LDS_BYTES) != hipSuccess) { fprintf(stderr, "kernel_launch: hipFuncSetAttribute failed\n"); grid = -1; return; }
        if (hipOccupancyMaxActiveBlocksPerMultiprocessor(&per_cu, (const void*)hybrid_fwd, 512, LDS_BYTES) != hipSuccess || per_cu < 1) { fprintf(stderr, "kernel_launch: occupancy query gives %d\n", per_cu); per_cu = 1; }
        (void)hipGetLastError();
        grid = cus * 1;
    }
    if (grid < 0) return;
    (void)hipMemsetAsync((char*)d_ws + WS_CTL, 0, 65536, stream);
    Args a{};
    for (int i = 0; i < 22; ++i) a.in[i] = (const float*)d_in[i];
    a.out = (float*)d_out; a.ws = (unsigned char*)d_ws; a.dbg = 0; a.pad = 0;
    void* kargs[] = {&a};
    hipError_t e = hipLaunchCooperativeKernel((const void*)hybrid_fwd, dim3(grid), dim3(512), kargs, LDS_BYTES, stream);
    if (e != hipSuccess) fprintf(stderr, "kernel_launch: cooperative launch failed: %s (grid %d)\n", hipGetErrorString(e), grid);
}
```

```cpp
#include <hip/hip_runtime.h>
#include <hip/hip_cooperative_groups.h>
#include <cstdio>
#include <cstdint>
namespace cg = cooperative_groups;
namespace pg8 {
#define PG8_LAS __attribute__((address_space(3)))
typedef unsigned short bf16_t;
typedef short bf16x8 __attribute__((ext_vector_type(8)));
typedef float f32x4 __attribute__((ext_vector_type(4)));
typedef unsigned u32x4 __attribute__((ext_vector_type(4)));
constexpr int BM = 256, BK = 64, HALF = 128, HTB = HALF * BK * 2  , STAGE_BYTES = 8 * HTB, NXCD = 8, WGM = 8;

__host__ __device__ __forceinline__ int lds_byte(int r, int c) { const int st = (r >> 4) * 2 + (c >> 5), rr = r & 15, cc = c & 31, ob = rr * 64 + cc * 2; return st * 1024 + (ob ^ (((ob >> 9) & 1) << 5)); }
__host__ __device__ __forceinline__ void stage_rc(int b, int& R, int& C) { const int st = b / 1024, sb = b % 1024, swz = sb ^ (((sb >> 9) & 1) << 5); R = (st >> 1) * 16 + swz / 64; C = (st & 1) * 32 + (swz % 64) / 2; }
__host__ __device__ __forceinline__ int perm32(int rho) { const int n = rho >> 4, i = rho & 15; return 8 * (i >> 2) + 4 * n + (i & 3); }

struct Unit { int pm, pn; };
struct Gemm { const bf16_t* A; const bf16_t* Bt; int M, N, K; };

struct StaticOrder {
    int nM, nN, nwg, G, c;
    __host__ __device__ void init(int M, int N, int G_, int c_) { nM = M / BM; nN = N / BM; nwg = nM * nN; G = G_; c = c_; }
    __host__ __device__ bool next(int i, Unit& u) const {
        const long L = (long)i * G + c; if (L >= nwg) return false;
        int wgid = (int)L; { const int q = nwg / NXCD, r = nwg % NXCD, xcd = wgid % NXCD, off = wgid / NXCD; wgid = (xcd < r ? xcd * (q + 1) : r * (q + 1) + (xcd - r) * q) + off; }
        const int nig = WGM * nN, gid = wgid / nig, fm = gid * WGM, gsz = (nM - fm) < WGM ? (nM - fm) : WGM;
        u.pm = fm + ((wgid % nig) % gsz); u.pn = (wgid % nig) / gsz; return true;
    }
    __device__ __forceinline__ void a_ready(const Unit&) const {}
    __device__ __forceinline__ void done(const Unit&) const {}
};
__device__ __forceinline__ unsigned cvt_pk_bf16(float lo, float hi) { unsigned r; asm volatile("v_cvt_pk_bf16_f32 %0, %1, %2" : "=v"(r) : "v"(lo), "v"(hi)); return r; }
typedef float f32x2 __attribute__((ext_vector_type(2)));
__device__ __forceinline__ f32x2 gelu_pk(f32x2 v) {
    const f32x2 av = __builtin_elementwise_abs(v), d = av * 0.2316418882f + 1.0f;
    f32x2 t; t.x = __builtin_amdgcn_rcpf(d.x); t.y = __builtin_amdgcn_rcpf(d.y);
    f32x2 q = t * 0.5307027145f + (-0.7265760135f); q = q * t + 0.7107068705f; q = q * t + (-0.142248368f); q = q * t + 0.127414796f; q = q * t;
    const f32x2 s = (v * v) * (-0.72134752044f);
    f32x2 e; e.x = __builtin_amdgcn_exp2f(s.x); e.y = __builtin_amdgcn_exp2f(s.y);
    const f32x2 m = v * (q * e), r = v - m;
    f32x2 o; o.x = v.x < 0.f ? m.x : r.x; o.y = v.y < 0.f ? m.y : r.y; return o;
}
template <class Epi, class Sched, bool ALIGN_EPI = false, bool SP2 = false>
__device__ __forceinline__ void gemm_phase(PG8_LAS unsigned char* lds, const Gemm g, const Sched& S, const Epi& E) {
    int tid_ = threadIdx.x; asm volatile("" : "+v"(tid_)); const int tid = tid_, wid = __builtin_amdgcn_readfirstlane(tid >> 6), lane = tid & 63, wr = wid >> 2, wc = wid & 3, fr = lane & 15, fq = lane >> 4;
    const int K = g.K, nt = K / BK;
    unsigned voffA[2], voffB[2];
#pragma unroll
    for (int i = 0; i < 2; ++i) { int R, C; stage_rc(tid * 16 + i * 8192, R, C); const int Rb = Epi::PERM ? ((R & ~31) + perm32(R & 31)) : R;
        voffA[i] = (unsigned)(R * K + C) * 2u; voffB[i] = (unsigned)(Rb * K + C) * 2u; }
    const size_t kstep = (size_t)(BK * 2);
    const size_t hstep = (size_t)HALF * K * 2;
    const size_t tstep = 2 * hstep;
    const unsigned ldsw = (unsigned)wid * 1024u;
    const int aoff = lds_byte(wr * 64 + fr, fq * 8), boff = lds_byte(wc * 32 + fr, fq * 8);
#define PG8_SA(b, h) (((b) * 2 + (h)) * HTB)
#define PG8_SB(b, h) ((4 + (b) * 2 + (h)) * HTB)
#define PG8_STAGE(bufoff, gbase, voff) do { _Pragma("unroll") for (int _i = 0; _i < 2; ++_i) \
        __builtin_amdgcn_global_load_lds((const unsigned*)((const char*)(gbase) + (voff)[_i]), (PG8_LAS unsigned*)(lds + (bufoff) + ldsw + _i * 8192), 16, 0, 0); } while (0)
#define PG8_LDA(dst, b, h) do { _Pragma("unroll") for (int m = 0; m < 4; ++m) _Pragma("unroll") for (int k = 0; k < 2; ++k) dst[m][k] = *(const PG8_LAS bf16x8*)(lds + PG8_SA(b, h) + aoff + m * 2048 + k * 1024); } while (0)
#define PG8_LDB(dst, b, h) do { _Pragma("unroll") for (int n = 0; n < 2; ++n) _Pragma("unroll") for (int k = 0; k < 2; ++k) dst[n][k] = *(const PG8_LAS bf16x8*)(lds + PG8_SB(b, h) + boff + n * 2048 + k * 1024); } while (0)
#define PG8_MMA(ai, bj, At, Bt) do { __builtin_amdgcn_s_setprio(1); _Pragma("unroll") for (int m = 0; m < 4; ++m) _Pragma("unroll") for (int n = 0; n < 2; ++n) _Pragma("unroll") for (int k = 0; k < 2; ++k) \
        acc[ai][bj][m][n] = __builtin_amdgcn_mfma_f32_16x16x32_bf16(Bt[n][k], At[m][k], acc[ai][bj][m][n], 0, 0, 0); __builtin_amdgcn_s_setprio(0); } while (0)
#define PG8_WAIT_V(n) asm volatile("s_waitcnt vmcnt(" #n ")" ::: "memory")
#define PG8_WAIT_L(n) asm volatile("s_waitcnt lgkmcnt(" #n ")" ::: "memory")
#define PG8_BAR __builtin_amdgcn_s_barrier()
#define PG8_SCHED __builtin_amdgcn_sched_barrier(0)
    Unit cur, nxt; int ui = 0;
    if (!S.next(0, cur)) return;
    f32x4 acc[2][2][4][2];
#pragma unroll
    for (int a = 0; a < 2; ++a)
#pragma unroll
        for (int b = 0; b < 2; ++b)
#pragma unroll
            for (int m = 0; m < 4; ++m)
#pragma unroll
                for (int n = 0; n < 2; ++n) acc[a][b][m][n] = (f32x4){0.f, 0.f, 0.f, 0.f};
    bf16x8 At[4][2], B0[2][2], B1[2][2];
    const char* cA = (const char*)g.A + (size_t)cur.pm * tstep; const char* cB = (const char*)g.Bt + (size_t)cur.pn * tstep;
    S.a_ready(cur);
    if constexpr (SP2) {
        PG8_STAGE(PG8_SB(0, 0), cB, voffB); PG8_STAGE(PG8_SB(0, 1), cB + hstep, voffB); PG8_STAGE(PG8_SA(0, 0), cA, voffA); PG8_STAGE(PG8_SA(0, 1), cA + hstep, voffA);
        if (wr == 1) PG8_BAR;
        PG8_WAIT_V(2); PG8_BAR;
        PG8_STAGE(PG8_SB(1, 0), cB + kstep, voffB); PG8_STAGE(PG8_SA(1, 0), cA + kstep, voffA); PG8_STAGE(PG8_SB(1, 1), cB + hstep + kstep, voffB);
        PG8_WAIT_V(6); PG8_BAR;
    } else {
        PG8_STAGE(PG8_SB(0, 0), cB, voffB); PG8_STAGE(PG8_SA(0, 0), cA, voffA); PG8_STAGE(PG8_SB(0, 1), cB + hstep, voffB); PG8_STAGE(PG8_SA(0, 1), cA + hstep, voffA);
        if (wr == 1) PG8_BAR;
        PG8_WAIT_V(4); PG8_BAR;
        PG8_STAGE(PG8_SB(1, 0), cB + kstep, voffB); PG8_STAGE(PG8_SA(1, 0), cA + kstep, voffA); PG8_STAGE(PG8_SB(1, 1), cB + hstep + kstep, voffB);
        PG8_WAIT_V(6); PG8_BAR;
    }
    for (;;) {
        const bool has_next = S.next(ui + 1, nxt);
        const char* nA = has_next ? (const char*)g.A + (size_t)nxt.pm * tstep : cA; const char* nB = has_next ? (const char*)g.Bt + (size_t)nxt.pn * tstep : cB;
        for (int t = 0; t < nt; t += 2) {
            const bool last = (t == nt - 2);
            const char* a1 = cA + (size_t)(t + 1) * kstep;
            const char* a2 = last ? nA : cA + (size_t)(t + 2) * kstep; const char* b2 = last ? nB : cB + (size_t)(t + 2) * kstep;
            const char* a3 = a2 + kstep; const char* b3 = b2 + kstep;
            if (last && has_next) S.a_ready(nxt);
            if constexpr (SP2) {
            PG8_LDB(B0, 0, 0); PG8_LDB(B1, 0, 1); PG8_SCHED; PG8_LDA(At, 0, 0); PG8_STAGE(PG8_SA(1, 1), a1 + hstep, voffA);
            PG8_WAIT_V(8); PG8_WAIT_L(0); PG8_BAR; PG8_MMA(0, 0, At, B0); PG8_MMA(0, 1, At, B1); PG8_BAR; PG8_SCHED;
            PG8_LDA(At, 0, 1); PG8_STAGE(PG8_SB(0, 0), b2, voffB); PG8_STAGE(PG8_SB(0, 1), b2 + hstep, voffB); PG8_STAGE(PG8_SA(0, 0), a2, voffA);
            PG8_WAIT_V(8); PG8_WAIT_L(0); PG8_BAR; PG8_MMA(1, 0, At, B0); PG8_MMA(1, 1, At, B1); PG8_BAR; PG8_SCHED;
            PG8_LDB(B0, 1, 0); PG8_LDB(B1, 1, 1); PG8_SCHED; PG8_LDA(At, 1, 0); PG8_STAGE(PG8_SA(0, 1), a2 + hstep, voffA);
            PG8_WAIT_V(8); PG8_WAIT_L(0); PG8_BAR; PG8_MMA(0, 0, At, B0); PG8_MMA(0, 1, At, B1); PG8_BAR; PG8_SCHED;
            PG8_LDA(At, 1, 1); PG8_STAGE(PG8_SB(1, 0), b3, voffB); PG8_STAGE(PG8_SB(1, 1), b3 + hstep, voffB); PG8_STAGE(PG8_SA(1, 0), a3, voffA);
            PG8_WAIT_V(8); PG8_WAIT_L(0); PG8_BAR; PG8_MMA(1, 0, At, B0); PG8_MMA(1, 1, At, B1); PG8_BAR; PG8_SCHED;
            } else {
            PG8_LDB(B0, 0, 0); PG8_SCHED; PG8_LDA(At, 0, 0); PG8_STAGE(PG8_SA(1, 1), a1 + hstep, voffA);
            PG8_WAIT_L(8); PG8_BAR; PG8_WAIT_L(0); PG8_MMA(0, 0, At, B0); PG8_BAR; PG8_SCHED;
            PG8_LDB(B1, 0, 1); PG8_STAGE(PG8_SB(0, 0), b2, voffB);
            PG8_BAR; PG8_WAIT_L(0); PG8_MMA(0, 1, At, B1); PG8_BAR;
            PG8_LDA(At, 0, 1); PG8_STAGE(PG8_SA(0, 0), a2, voffA);
            PG8_BAR; PG8_WAIT_L(0); PG8_MMA(1, 0, At, B0); PG8_BAR; PG8_SCHED;
            PG8_STAGE(PG8_SB(0, 1), b2 + hstep, voffB);
            PG8_WAIT_V(6); PG8_BAR; PG8_MMA(1, 1, At, B1); PG8_BAR;
            PG8_LDB(B0, 1, 0); PG8_SCHED; PG8_LDA(At, 1, 0); PG8_STAGE(PG8_SA(0, 1), a2 + hstep, voffA);
            PG8_WAIT_L(8); PG8_BAR; PG8_WAIT_L(0); PG8_MMA(0, 0, At, B0); PG8_BAR; PG8_SCHED;
            PG8_LDB(B1, 1, 1); PG8_STAGE(PG8_SB(1, 0), b3, voffB);
            PG8_BAR; PG8_WAIT_L(0); PG8_MMA(0, 1, At, B1); PG8_BAR;
            PG8_LDA(At, 1, 1); PG8_STAGE(PG8_SA(1, 0), a3, voffA);
            PG8_BAR; PG8_WAIT_L(0); PG8_MMA(1, 0, At, B0); PG8_BAR; PG8_SCHED;
            PG8_STAGE(PG8_SB(1, 1), b3 + hstep, voffB);
            PG8_WAIT_V(6); PG8_BAR; PG8_MMA(1, 1, At, B1); PG8_BAR;
            }
        }
        if constexpr (ALIGN_EPI) { if (wr == 0) PG8_BAR; }
        if constexpr (!Epi::AFTER_DRAIN) { E(acc, cur, wr, wc, fr, fq); S.done(cur); }
        if (!has_next) break;
#pragma unroll
        for (int a = 0; a < 2; ++a)
#pragma unroll
            for (int b = 0; b < 2; ++b)
#pragma unroll
                for (int m = 0; m < 4; ++m)
#pragma unroll
                    for (int n = 0; n < 2; ++n) acc[a][b][m][n] = (f32x4){0.f, 0.f, 0.f, 0.f};
        cur = nxt; cA = nA; cB = nB; ++ui;
        if constexpr (ALIGN_EPI) { if (wr == 1) PG8_BAR; }
    }
    PG8_WAIT_V(0);
    if constexpr (!ALIGN_EPI) { if (wr == 0) PG8_BAR; }
    PG8_BAR;
    if constexpr (Epi::AFTER_DRAIN) { E.fused(acc, cur, wr, wc, fr, fq, lds, wid, lane); S.done(cur); }
#undef PG8_SA
#undef PG8_SB
#undef PG8_STAGE
#undef PG8_LDA
#undef PG8_LDB
#undef PG8_MMA
#undef PG8_WAIT_V
#undef PG8_WAIT_L
#undef PG8_BAR
#undef PG8_SCHED
}
}

using pg8::bf16_t; using pg8::bf16x8; using pg8::f32x4; using pg8::u32x4; using pg8::Unit;
typedef _Float16 h16x8 __attribute__((ext_vector_type(8)));
typedef unsigned u32x2 __attribute__((ext_vector_type(2)));
#ifndef PROBE
#define PROBE 0
#endif
constexpr bool GEMM_ALIGN = true, GEMM_SP2 = true;
constexpr int DM = 2048, NBATCH = 8, SEQ = 2048, CTXL = 256, MLAT = NBATCH * SEQ, MCTX = NBATCH * CTXL, MTOT = MLAT + MCTX;
constexpr int DFF = 5504, NMOD = 6 * DM;
constexpr float ALPHA_F = 1.4142135623730951f;
constexpr float LN_EPS_F = 1e-6f, RMS_EPS_F = 1e-5f;
constexpr float LAM_INIT0 = 0.2f;
constexpr float QSCALE = 0.125f * 1.4426950408889634f;

constexpr size_t MiB = 1u << 20;
constexpr size_t WS_CTL = 0;
constexpr size_t WS_MODV = 1 * MiB;
constexpr size_t WS_ROPE = 2 * MiB;
constexpr size_t WS_W0QK = 4 * MiB;
constexpr size_t WS_W0VF = 16 * MiB;
constexpr size_t WS_W0OUT = 26 * MiB;
constexpr size_t WS_W1A = 34 * MiB;
constexpr size_t WS_W1V = 66 * MiB;
constexpr size_t WS_W1OUT = 74 * MiB;
constexpr size_t WS_WUP = 82 * MiB;
constexpr size_t WS_WDN = 168 * MiB;
constexpr size_t WS_D2 = 211 * MiB;
constexpr size_t WS_D2C = 227 * MiB;
constexpr size_t WS_HCTX = 228 * MiB;
constexpr size_t WS_U = 244 * MiB;
constexpr size_t WS_R = 316 * MiB;
constexpr size_t WS_END = 768 * MiB;
constexpr size_t R_QK = WS_R;
constexpr size_t R_VT0 = WS_R + 108 * MiB;
constexpr size_t R_FTL = WS_R + 162 * MiB;
constexpr size_t R_FTC = WS_R + 194 * MiB;
constexpr size_t R_CAT = WS_R + 198 * MiB;
constexpr size_t R_A1 = WS_R;
constexpr size_t R_V1 = WS_R + 194 * MiB;
constexpr size_t R_MB = WS_R + 272 * MiB;
constexpr size_t R_EDGE = WS_R + 390 * MiB;
constexpr size_t R_Q1 = WS_R;
constexpr size_t R_LF = WS_R + 72 * MiB;
constexpr size_t R_G1 = WS_R + 216 * MiB;
constexpr size_t R_VT1 = WS_R + 288 * MiB;
constexpr size_t R_OB = WS_R + 360 * MiB;

constexpr int LDS_BYTES = 152576;
constexpr int LDS_MISC = 147456;

struct Args {
    const float* in[22]; float* out; unsigned char* ws; int dbg; int pad;
};

__device__ __forceinline__ float bf2f(unsigned short v) { return __builtin_bit_cast(float, (unsigned)v << 16); }
__device__ __forceinline__ unsigned f2bf(float f) { return pg8::cvt_pk_bf16(f, f) & 0xffffu; }
__device__ __forceinline__ unsigned pk2(float lo, float hi) { return pg8::cvt_pk_bf16(lo, hi); }
__device__ __forceinline__ float wave_sum(float v) {
#pragma unroll
    for (int o = 1; o < 64; o <<= 1) v += __shfl_xor(v, o);
    return v;
}
__device__ __forceinline__ float silu_f(float x) { return x * __builtin_amdgcn_rcpf(1.0f + __expf(-x)); }
__device__ __forceinline__ float sigmoid_f(float x) { return __builtin_amdgcn_rcpf(1.0f + __expf(-x)); }
__device__ __forceinline__ float gelu_f(float v) {
    const float av = fabsf(v), t = __builtin_amdgcn_rcpf(av * 0.2316418882f + 1.0f);
    float q = t * 0.5307027145f + (-0.7265760135f); q = q * t + 0.7107068705f; q = q * t + (-0.142248368f); q = q * t + 0.127414796f; q = q * t;
    const float e = __builtin_amdgcn_exp2f((v * v) * (-0.72134752044f));
    const float m = v * (q * e);
    return v < 0.f ? m : v - m;
}

struct EpiQK {
    static constexpr bool PERM = true, AFTER_DRAIN = false;
    bf16_t* O; const float* rope;
    __device__ __forceinline__ void operator()(const f32x4 (&acc)[2][2][4][2], const Unit& u, int wr, int wc, int fr, int fq) const {
        const int row0 = u.pm * 256 + wr * 64 + fr;
        const int colt = u.pn * 256;
        const bool isq = colt < 1536;
        const float sc = isq ? QSCALE : 1.0f;
        const bool lat = (u.pm < 64);
        const int axis = wc & 1;
        const bool second = fq >= 2;
        const int i0 = 8 * (fq & 1);
#pragma unroll
        for (int ai = 0; ai < 2; ++ai)
#pragma unroll
            for (int m = 0; m < 4; ++m) {
                const int row = row0 + ai * 128 + m * 16;
                f32x4 c0 = {1.f, 1.f, 1.f, 1.f}, c1 = c0, s0 = {0.f, 0.f, 0.f, 0.f}, s1 = s0;
                if (lat) {
                    const int t = row & 2047, pos = axis ? (t & 63) : (t >> 6);
                    const float* cp = rope + pos * 16 + i0;
                    c0 = *(const f32x4*)cp; c1 = *(const f32x4*)(cp + 4); s0 = *(const f32x4*)(cp + 1024); s1 = *(const f32x4*)(cp + 1028);
                }
                bf16_t* rowp = O + (size_t)row * 3072 + colt + wc * 32 + 8 * fq;
#pragma unroll
                for (int bj = 0; bj < 2; ++bj) {
                    f32x4 v0 = acc[ai][bj][m][0], v1 = acc[ai][bj][m][1];
                    if (lat) {
                        f32x4 p0, p1;
#pragma unroll
                        for (int j = 0; j < 4; ++j) { p0[j] = __shfl_xor(v0[j], 32); p1[j] = __shfl_xor(v1[j], 32); }
                        if (second) { v0 = v0 * c0 + p0 * s0; v1 = v1 * c1 + p1 * s1; }
                        else        { v0 = v0 * c0 - p0 * s0; v1 = v1 * c1 - p1 * s1; }
                    }
                    v0 = v0 * sc; v1 = v1 * sc;
                    u32x4 w; w.x = pg8::cvt_pk_bf16(v0[0], v0[1]); w.y = pg8::cvt_pk_bf16(v0[2], v0[3]); w.z = pg8::cvt_pk_bf16(v1[0], v1[1]); w.w = pg8::cvt_pk_bf16(v1[2], v1[3]);
                    *(u32x4*)(rowp + bj * 128) = w;
                }
            }
    }
};
struct EpiT {
    static constexpr bool PERM = true, AFTER_DRAIN = false;
    bf16_t* VT; bf16_t* FTL; bf16_t* FTC; int mode;
    __device__ __forceinline__ void operator()(const f32x4 (&acc)[2][2][4][2], const Unit& u, int wr, int wc, int fr, int fq) const {
        const int row0 = u.pm * 256 + wr * 64 + fr;
        const int col0 = u.pn * 256 + wc * 32 + 8 * fq;
#pragma unroll
        for (int ai = 0; ai < 2; ++ai)
#pragma unroll
            for (int m = 0; m < 4; ++m) {
                const int row = row0 + ai * 128 + m * 16;
#pragma unroll
                for (int bj = 0; bj < 2; ++bj) {
                    const int col = col0 + bj * 128;
                    const f32x4 v0 = acc[ai][bj][m][0], v1 = acc[ai][bj][m][1];
                    u32x4 w; w.x = pg8::cvt_pk_bf16(v0[0], v0[1]); w.y = pg8::cvt_pk_bf16(v0[2], v0[3]); w.z = pg8::cvt_pk_bf16(v1[0], v1[1]); w.w = pg8::cvt_pk_bf16(v1[2], v1[3]);
                    bf16_t* dst;
                    if (mode == 1 || row < 1536) dst = VT + (size_t)row * MTOT + col;
                    else {
                        const int rr = row - 1536, part = rr >> 9, j = rr & 511;
                        if (col < MLAT) { const int b = col >> 11, t = col & 2047; dst = FTL + ((size_t)(b * 512 + j) * 4096 + part * 2048 + t); }
                        else { const int cc = col - MLAT, b = cc >> 8, t = cc & 255; dst = FTC + ((size_t)(b * 512 + j) * 512 + part * 256 + t); }
                    }
                    *(u32x4*)dst = w;
                }
            }
    }
};
struct EpiFour {
    static constexpr bool PERM = true, AFTER_DRAIN = false;
    bf16_t* CAT; int rowbase, L; float scale;
    __device__ __forceinline__ void operator()(const f32x4 (&acc)[2][2][4][2], const Unit& u, int wr, int wc, int fr, int fq) const {
        const int row0 = u.pm * 256 + wr * 64 + fr;
        const int b = u.pn >> 1;
        const int j0 = (u.pn & 1) * 256 + wc * 32 + 8 * fq;
#pragma unroll
        for (int ai = 0; ai < 2; ++ai)
#pragma unroll
            for (int m = 0; m < 4; ++m) {
                const int k = row0 + ai * 128 + m * 16;
                bf16_t* rowp = CAT + (size_t)(rowbase + b * L + k) * 2048 + 1536 + j0;
#pragma unroll
                for (int bj = 0; bj < 2; ++bj) {
                    const f32x4 v0 = acc[ai][bj][m][0] * scale, v1 = acc[ai][bj][m][1] * scale;
                    u32x4 w; w.x = pg8::cvt_pk_bf16(v0[0], v0[1]); w.y = pg8::cvt_pk_bf16(v0[2], v0[3]); w.z = pg8::cvt_pk_bf16(v1[0], v1[1]); w.w = pg8::cvt_pk_bf16(v1[2], v1[3]);
                    *(u32x4*)(rowp + bj * 128) = w;
                }
            }
    }
};
struct EpiResid {
    static constexpr bool PERM = true, AFTER_DRAIN = false;
    bf16_t* MB; const float* gate;
    __device__ __forceinline__ void operator()(const f32x4 (&acc)[2][2][4][2], const Unit& u, int wr, int wc, int fr, int fq) const {
        const int row0 = u.pm * 256 + wr * 64 + fr, col0 = u.pn * 256 + wc * 32 + 8 * fq;
        const int r = u.pm < 64 ? (u.pm >> 3) : 8;
        const float* gp = gate + r * NMOD + col0;
        f32x4 g[2][2];
#pragma unroll
        for (int bj = 0; bj < 2; ++bj)
#pragma unroll
            for (int n = 0; n < 2; ++n) g[bj][n] = *(const f32x4*)(gp + bj * 128 + 4 * n);
#pragma unroll
        for (int ai = 0; ai < 2; ++ai)
#pragma unroll
            for (int m = 0; m < 4; ++m) {
                bf16_t* rowp = MB + (size_t)(row0 + ai * 128 + m * 16) * DM + col0;
#pragma unroll
                for (int bj = 0; bj < 2; ++bj) {
                    const f32x4 v0 = acc[ai][bj][m][0] * g[bj][0], v1 = acc[ai][bj][m][1] * g[bj][1];
                    u32x4 w; w.x = pg8::cvt_pk_bf16(v0[0], v0[1]); w.y = pg8::cvt_pk_bf16(v0[2], v0[3]); w.z = pg8::cvt_pk_bf16(v1[0], v1[1]); w.w = pg8::cvt_pk_bf16(v1[2], v1[3]);
                    *(u32x4*)(rowp + bj * 128) = w;
                }
            }
    }
};
struct EpiUp {
    static constexpr bool PERM = true, AFTER_DRAIN = false;
    bf16_t* A1; bf16_t* V1;
    __device__ __forceinline__ void operator()(const f32x4 (&acc)[2][2][4][2], const Unit& u, int wr, int wc, int fr, int fq) const {
        const int row0 = u.pm * 256 + wr * 64 + fr, col0 = u.pn * 128 + wc * 32 + 8 * fq;
#pragma unroll
        for (int ai = 0; ai < 2; ++ai)
#pragma unroll
            for (int m = 0; m < 4; ++m) {
                const size_t off = (size_t)(row0 + ai * 128 + m * 16) * DFF + col0;
#pragma unroll
                for (int bj = 0; bj < 2; ++bj) {
                    const f32x4 v0 = acc[ai][bj][m][0], v1 = acc[ai][bj][m][1];
                    u32x4 w; w.x = pg8::cvt_pk_bf16(v0[0], v0[1]); w.y = pg8::cvt_pk_bf16(v0[2], v0[3]); w.z = pg8::cvt_pk_bf16(v1[0], v1[1]); w.w = pg8::cvt_pk_bf16(v1[2], v1[3]);
                    *(u32x4*)((bj ? V1 : A1) + off) = w;
                }
            }
    }
};
__device__ __forceinline__ float dpp_ror1(float x) { return __builtin_bit_cast(float, __builtin_amdgcn_update_dpp(0, __builtin_bit_cast(int, x), 0x121, 0xf, 0xf, false)); }
__device__ __forceinline__ float dpp_rol1(float x) { return __builtin_bit_cast(float, __builtin_amdgcn_update_dpp(0, __builtin_bit_cast(int, x), 0x12F, 0xf, 0xf, false)); }
struct EpiUpFused {
    static constexpr bool PERM = true, AFTER_DRAIN = false;
    bf16_t* HID; float* EA; float* EP; float* EV; const float* cw; const float* cb; float* xch;
    __device__ __forceinline__ void operator()(const f32x4 (&acc)[2][2][4][2], const Unit& u, int wr, int wc, int fr, int fq) const {
        const int lc0 = wc * 32 + 8 * fq, col0 = u.pn * 128 + lc0;
        const int row0 = u.pm * 256 + wr * 64 + fr;
#pragma unroll
        for (int ai = 0; ai < 2; ++ai) {
            const int sg = ai * 2 + wr;
            if (fr == 0) { *(f32x4*)(xch + (sg * 2 + 0) * 128 + lc0) = acc[ai][0][0][0]; *(f32x4*)(xch + (sg * 2 + 0) * 128 + lc0 + 4) = acc[ai][0][0][1]; }
            if (fr == 15) { *(f32x4*)(xch + (sg * 2 + 1) * 128 + lc0) = acc[ai][0][3][0]; *(f32x4*)(xch + (sg * 2 + 1) * 128 + lc0 + 4) = acc[ai][0][3][1]; }
        }
        asm volatile("s_waitcnt lgkmcnt(0)" ::: "memory");
        __builtin_amdgcn_s_barrier();
        asm volatile("" ::: "memory");
        f32x4 w0[2], w1[2], w2[2], bb[2];
#pragma unroll
        for (int n = 0; n < 2; ++n) { w0[n] = *(const f32x4*)(cw + col0 + 4 * n); w1[n] = *(const f32x4*)(cw + DFF + col0 + 4 * n); w2[n] = *(const f32x4*)(cw + 2 * DFF + col0 + 4 * n); bb[n] = *(const f32x4*)(cb + col0 + 4 * n); }
#pragma unroll
        for (int ai = 0; ai < 2; ++ai) {
            const int sg = ai * 2 + wr;
            f32x4 extp[2], extn[2];
#pragma unroll
            for (int n = 0; n < 2; ++n) {
                extp[n] = sg > 0 ? *(const f32x4*)(xch + ((sg - 1) * 2 + 1) * 128 + lc0 + 4 * n) : (f32x4){0.f, 0.f, 0.f, 0.f};
                extn[n] = sg < 3 ? *(const f32x4*)(xch + ((sg + 1) * 2 + 0) * 128 + lc0 + 4 * n) : (f32x4){0.f, 0.f, 0.f, 0.f};
            }
            f32x4 hid[4][2], cvs[4][2];
#pragma unroll
            for (int n = 0; n < 2; ++n)
#pragma unroll
                for (int j = 0; j < 4; ++j) {
                    float a[4], r[4], l[4];
#pragma unroll
                    for (int m = 0; m < 4; ++m) { a[m] = acc[ai][0][m][n][j]; r[m] = dpp_ror1(a[m]); l[m] = dpp_rol1(a[m]); }
#pragma unroll
                    for (int m = 0; m < 4; ++m) {
                        const float pv = fr > 0 ? r[m] : (m > 0 ? r[m > 0 ? m - 1 : 0] : extp[n][j]);
                        const float nv = fr < 15 ? l[m] : (m < 3 ? l[m < 3 ? m + 1 : 3] : extn[n][j]);
                        const float cv = bb[n][j] + pv * w0[n][j] + a[m] * w1[n][j] + nv * w2[n][j];
                        cvs[m][n][j] = cv;
                        hid[m][n][j] = gelu_f(cv) * acc[ai][1][m][n][j];
                    }
                }
#pragma unroll
            for (int m = 0; m < 4; ++m) {
                u32x4 w; w.x = pg8::cvt_pk_bf16(hid[m][0][0], hid[m][0][1]); w.y = pg8::cvt_pk_bf16(hid[m][0][2], hid[m][0][3]); w.z = pg8::cvt_pk_bf16(hid[m][1][0], hid[m][1][1]); w.w = pg8::cvt_pk_bf16(hid[m][1][2], hid[m][1][3]);
                *(u32x4*)(HID + (size_t)(row0 + ai * 128 + m * 16) * DFF + col0) = w;
            }
            if (sg == 0 && fr == 0) {
                const size_t eo = (size_t)(u.pm * 2 + 0) * DFF + col0;
#pragma unroll
                for (int n = 0; n < 2; ++n) { *(f32x4*)(EA + eo + 4 * n) = acc[ai][0][0][n]; *(f32x4*)(EP + eo + 4 * n) = cvs[0][n]; *(f32x4*)(EV + eo + 4 * n) = acc[ai][1][0][n]; }
            }
            if (sg == 3 && fr == 15) {
                const size_t eo = (size_t)(u.pm * 2 + 1) * DFF + col0;
#pragma unroll
                for (int n = 0; n < 2; ++n) { *(f32x4*)(EA + eo + 4 * n) = acc[ai][0][3][n]; *(f32x4*)(EP + eo + 4 * n) = cvs[3][n]; *(f32x4*)(EV + eo + 4 * n) = acc[ai][1][3][n]; }
            }
        }
    }
};
struct EpiH1 {
    static constexpr bool PERM = true, AFTER_DRAIN = false;
    bf16_t* Q1; _Float16* LF; bf16_t* G1; const float* lbraw; int row_off, pn_off;
    __device__ __forceinline__ void operator()(const f32x4 (&acc)[2][2][4][2], const Unit& u, int wr, int wc, int fr, int fq) const {
        const int row0 = row_off + u.pm * 256 + wr * 64 + fr;
        const int pnn = u.pn + pn_off;
        const int seg = pnn >> 3;
        const int cs0 = (pnn & 7) * 256 + wc * 32 + 8 * fq;
        if (seg == 0 || seg == 3) {
            bf16_t* O = seg == 0 ? Q1 : G1;
#pragma unroll
            for (int ai = 0; ai < 2; ++ai)
#pragma unroll
                for (int m = 0; m < 4; ++m) {
                    bf16_t* rowp = O + (size_t)(row0 + ai * 128 + m * 16) * DM + cs0;
#pragma unroll
                    for (int bj = 0; bj < 2; ++bj) {
                        f32x4 v0 = acc[ai][bj][m][0], v1 = acc[ai][bj][m][1];
#pragma unroll
                        for (int j = 0; j < 4; ++j) { v0[j] = silu_f(v0[j]); v1[j] = silu_f(v1[j]); }
                        u32x4 w; w.x = pg8::cvt_pk_bf16(v0[0], v0[1]); w.y = pg8::cvt_pk_bf16(v0[2], v0[3]); w.z = pg8::cvt_pk_bf16(v1[0], v1[1]); w.w = pg8::cvt_pk_bf16(v1[2], v1[3]);
                        *(u32x4*)(rowp + bj * 128) = w;
                    }
                }
        } else {
            const int d = seg - 1;
            _Float16* O = LF + (size_t)d * MTOT * DM;
            float lb[2][8];
#pragma unroll
            for (int bj = 0; bj < 2; ++bj)
#pragma unroll
                for (int e = 0; e < 8; ++e) {
                    const int c = cs0 + bj * 128 + e;
                    lb[bj][e] = sigmoid_f(lbraw[(d * 2 + 1) * DM + c] - lbraw[(d * 2 + 0) * DM + c]);
                }
#pragma unroll
            for (int ai = 0; ai < 2; ++ai)
#pragma unroll
                for (int m = 0; m < 4; ++m) {
                    _Float16* rowp = O + (size_t)(row0 + ai * 128 + m * 16) * DM + cs0;
#pragma unroll
                    for (int bj = 0; bj < 2; ++bj) {
                        h16x8 w;
#pragma unroll
                        for (int e = 0; e < 8; ++e) {
                            const float x = (e < 4) ? acc[ai][bj][m][0][e & 3] : acc[ai][bj][m][1][e & 3];
                            const float f = lb[bj][e] + (1.0f - lb[bj][e]) * sigmoid_f(x);
                            w[e] = (_Float16)__logf(f);
                        }
                        *(h16x8*)(rowp + bj * 128) = w;
                    }
                }
        }
    }
};

#define LDS_WAIT() asm volatile("s_waitcnt lgkmcnt(0)" ::: "memory")
__device__ __forceinline__ void transpose_item(const float* W, int ldw, int k0, int n0, bf16_t* WT, int K, int drow0, float* scr, int lane) {
    f32x4 v[8];
    const int kr = lane >> 3, c4 = (lane & 7) * 4;
#pragma unroll
    for (int i = 0; i < 8; ++i) v[i] = *(const f32x4*)(W + (size_t)(k0 + kr + 8 * i) * ldw + n0 + c4);
#pragma unroll
    for (int i = 0; i < 8; ++i) { float* s = scr + (kr + 8 * i) * 33 + c4; s[0] = v[i][0]; s[1] = v[i][1]; s[2] = v[i][2]; s[3] = v[i][3]; }
    LDS_WAIT(); asm volatile("" ::: "memory");
    const int c = lane & 7;
#pragma unroll
    for (int j = 0; j < 4; ++j) { const int n = (lane >> 3) + 8 * j; const float* s = scr + (8 * c) * 33 + n;
        u32x4 o; o.x = pk2(s[0 * 33], s[1 * 33]); o.y = pk2(s[2 * 33], s[3 * 33]); o.z = pk2(s[4 * 33], s[5 * 33]); o.w = pk2(s[6 * 33], s[7 * 33]);
        *(u32x4*)(WT + (size_t)(drow0 + n) * K + k0 + 8 * c) = o; }
    LDS_WAIT(); asm volatile("" ::: "memory");
}
struct TJob { const float* W; int ldw, K, ncols, col0; bf16_t* WT; int mode; };
__device__ __forceinline__ int tjob_items(const TJob& j) { return (j.K / 64) * (j.ncols / 32); }
__device__ __forceinline__ void tjob_run(const TJob& j, int drow_base, int it, float* scr, int lane) {
    const int nblk = j.ncols / 32, kb = it / nblk, nb = it % nblk;
    const int n = nb * 32;
    int drow;
    if (j.mode == 0) drow = drow_base + n;
    else { const int bj = n / DFF, r = n % DFF, pn = r >> 7, i = r & 127; drow = 256 * pn + 128 * bj + i; }
    transpose_item(j.W, j.ldw, kb * 64, j.col0 + n, j.WT, j.K, drow, scr, lane);
}

__device__ __forceinline__ void row_op(const float* zrow, float* hrow, const float* g, const float* bt, bool ln1, const float* sh, const float* sc, bf16_t* urow, int lane, const bf16_t* mrow = nullptr, const f32x4* gpre = nullptr, const f32x4* bpre = nullptr) {
    f32x4 v[8];
    const f32x4* zr = (const f32x4*)zrow + lane;
#pragma unroll
    for (int j = 0; j < 8; ++j) v[j] = zr[64 * j];
    if (mrow) {
#pragma unroll
        for (int j = 0; j < 8; ++j) {
            const u32x2 mw = *((const u32x2*)mrow + lane + 64 * j);
            v[j][0] = v[j][0] * ALPHA_F + bf2f((unsigned short)(mw.x & 0xffffu)); v[j][1] = v[j][1] * ALPHA_F + bf2f((unsigned short)(mw.x >> 16));
            v[j][2] = v[j][2] * ALPHA_F + bf2f((unsigned short)(mw.y & 0xffffu)); v[j][3] = v[j][3] * ALPHA_F + bf2f((unsigned short)(mw.y >> 16));
        }
    }
    if (ln1) {
        float s = 0.f;
#pragma unroll
        for (int j = 0; j < 8; ++j) s += (v[j][0] + v[j][1]) + (v[j][2] + v[j][3]);
        const float mean = wave_sum(s) * (1.f / DM); float s2 = 0.f;
#pragma unroll
        for (int j = 0; j < 8; ++j) { v[j] = v[j] - mean; s2 += (v[j][0] * v[j][0] + v[j][1] * v[j][1]) + (v[j][2] * v[j][2] + v[j][3] * v[j][3]); }
        const float rstd = 1.f / sqrtf(wave_sum(s2) * (1.f / DM) + LN_EPS_F);
#pragma unroll
        for (int j = 0; j < 8; ++j) { const f32x4 gg = gpre ? gpre[j] : *((const f32x4*)g + lane + 64 * j), bb = bpre ? bpre[j] : *((const f32x4*)bt + lane + 64 * j); v[j] = v[j] * rstd * gg + bb; }
        if (hrow) {
#pragma unroll
            for (int j = 0; j < 8; ++j) *((f32x4*)hrow + lane + 64 * j) = v[j];
        }
    }
    if (urow) {
        float s = 0.f;
#pragma unroll
        for (int j = 0; j < 8; ++j) s += (v[j][0] + v[j][1]) + (v[j][2] + v[j][3]);
        const float mean = wave_sum(s) * (1.f / DM); float s2 = 0.f;
#pragma unroll
        for (int j = 0; j < 8; ++j) { v[j] = v[j] - mean; s2 += (v[j][0] * v[j][0] + v[j][1] * v[j][1]) + (v[j][2] * v[j][2] + v[j][3] * v[j][3]); }
        const float rstd = 1.f / sqrtf(wave_sum(s2) * (1.f / DM) + LN_EPS_F);
#pragma unroll
        for (int j = 0; j < 8; ++j) {
            const f32x4 scv = *((const f32x4*)sc + lane + 64 * j), shv = *((const f32x4*)sh + lane + 64 * j);
            const f32x4 o = v[j] * rstd * (scv + 1.0f) + shv;
            u32x2 w; w.x = pk2(o[0], o[1]); w.y = pk2(o[2], o[3]);
            *((u32x2*)urow + lane + 64 * j) = w;
        }
    }
}

__device__ __forceinline__ void attn_unit(unsigned char* lds, const bf16_t* QK, const bf16_t* VT0, bf16_t* CAT, const float* subln, float lam, int unit) {
    int tid_ = threadIdx.x; asm volatile("" : "+v"(tid_)); const int tid = tid_, lane = tid & 63, wave = tid >> 6, fr = lane & 15, fq = lane >> 4;
    const int qg = wave >> 1, sm = wave & 1;
    int b, h, qrow0, ntiles;
    int rot = 0;
    if (unit < 1536) { b = unit / 192; const int rem = unit % 192; h = rem >> 4; qrow0 = b * SEQ + (rem & 15) * 128; ntiles = 36; rot = ((rem & 15) * 9) >> 2; }
    else { const int uu = unit - 1536; b = uu / 24; const int rem = uu % 24; h = rem >> 1; qrow0 = MLAT + b * CTXL + (rem & 1) * 128; ntiles = 4; }
    bf16_t* Kt0 = (bf16_t*)lds;
    float* XO = (float*)lds;
    bf16x8 q[2][2];
#pragma unroll
    for (int qt = 0; qt < 2; ++qt)
#pragma unroll
        for (int kk = 0; kk < 2; ++kk)
            q[qt][kk] = *(const bf16x8*)(QK + (size_t)(qrow0 + qg * 32 + qt * 16 + fr) * 3072 + h * 128 + sm * 64 + kk * 32 + fq * 8);
    f32x4 O[2][8];
#pragma unroll
    for (int qt = 0; qt < 2; ++qt)
#pragma unroll
        for (int dt = 0; dt < 8; ++dt) O[qt][dt] = (f32x4){0.f, 0.f, 0.f, 0.f};
    float mrun[2] = {-INFINITY, -INFINITY}, lrun[2] = {0.f, 0.f};
    u32x4 kreg[2], vreg[2];
#define keyrow_(i) ((i) < 4 ? (MLAT + b * CTXL + 64 * (i)) : (b * SEQ + 64 * ((i) - 4)))
#define keyrow(i) keyrow_(((i) + rot) % ntiles)
#define AT_LOAD(i_) do { const int kr0 = keyrow(i_); _Pragma("unroll") for (int c = 0; c < 2; ++c) { const int id = tid + 512 * c; \
            kreg[c] = *(const u32x4*)(QK + (size_t)(kr0 + (id >> 4)) * 3072 + 1536 + h * 128 + (id & 15) * 8); \
            vreg[c] = *(const u32x4*)(VT0 + (size_t)(h * 128 + (id >> 3)) * MTOT + kr0 + (id & 7) * 8); } } while (0)
#define AT_STORE(buf_) do { bf16_t* Kb = Kt0 + (buf_) * 18432; bf16_t* Vb = Kb + 8704; _Pragma("unroll") for (int c = 0; c < 2; ++c) { const int id = tid + 512 * c; \
            *(u32x4*)(Kb + (id >> 4) * 136 + (id & 15) * 8) = kreg[c]; \
            *(u32x4*)(Vb + (id >> 3) * 72 + (id & 7) * 8) = vreg[c]; } } while (0)
    __syncthreads();
    AT_LOAD(0); AT_STORE(0);
    if (ntiles > 1) AT_LOAD(1);
    __syncthreads();
    const bool grpB = wave >= 4;
    bf16x8 pb[2][2];
#define AT_PV(Vt_) do { _Pragma("unroll") for (int hf = 0; hf < 2; ++hf) { bf16x8 av_[8]; \
        _Pragma("unroll") for (int d4 = 0; d4 < 4; ++d4) _Pragma("unroll") for (int kk = 0; kk < 2; ++kk) { const int dt = hf * 4 + d4; \
            const u32x2 lo = *(const u32x2*)((Vt_) + (dt * 16 + fr) * 72 + kk * 32 + 4 * fq); \
            const u32x2 hi = *(const u32x2*)((Vt_) + (dt * 16 + fr) * 72 + kk * 32 + 16 + 4 * fq); \
            u32x4 w; w.x = lo.x; w.y = lo.y; w.z = hi.x; w.w = hi.y; av_[d4 * 2 + kk] = __builtin_bit_cast(bf16x8, w); } \
        __builtin_amdgcn_sched_barrier(0); \
        _Pragma("unroll") for (int d4 = 0; d4 < 4; ++d4) _Pragma("unroll") for (int kk = 0; kk < 2; ++kk) \
            _Pragma("unroll") for (int qt = 0; qt < 2; ++qt) O[qt][hf * 4 + d4] = __builtin_amdgcn_mfma_f32_16x16x32_bf16(av_[d4 * 2 + kk], pb[qt][kk], O[qt][hf * 4 + d4], 0, 0, 0); \
        __builtin_amdgcn_sched_barrier(0); } } while (0)
    int rb = 0;
    for (int i = 0; i <= ntiles; ++i) {
        const int rbn = rb == 2 ? 0 : rb + 1, rbp = rb == 0 ? 2 : rb - 1;
        const bf16_t* Kt = Kt0 + rb * 18432;
        if (i + 1 < ntiles) AT_STORE(rbn);
        if (i + 2 < ntiles) AT_LOAD(i + 2);
        if (grpB && i > 0) AT_PV(Kt0 + rbp * 18432 + 8704);
        if (i < ntiles) {
        f32x4 s[4][2];
#pragma unroll
        for (int kt = 0; kt < 4; ++kt) {
            const bf16x8 a0 = *(const bf16x8*)(Kt + (kt * 16 + fr) * 136 + sm * 64 + fq * 8);
            const bf16x8 a1 = *(const bf16x8*)(Kt + (kt * 16 + fr) * 136 + sm * 64 + 32 + fq * 8);
#pragma unroll
            for (int qt = 0; qt < 2; ++qt) {
                f32x4 z = {0.f, 0.f, 0.f, 0.f};
                z = __builtin_amdgcn_mfma_f32_16x16x32_bf16(a0, q[qt][0], z, 0, 0, 0);
                s[kt][qt] = __builtin_amdgcn_mfma_f32_16x16x32_bf16(a1, q[qt][1], z, 0, 0, 0);
            }
        }
#pragma unroll
        for (int qt = 0; qt < 2; ++qt) {
            float mx = -INFINITY;
#pragma unroll
            for (int kt = 0; kt < 4; ++kt)
#pragma unroll
                for (int j = 0; j < 4; ++j) mx = fmaxf(mx, s[kt][qt][j]);
            if (__builtin_amdgcn_ballot_w64(mx > mrun[qt] + 40.0f) != 0ull) {
                mx = fmaxf(mx, __shfl_xor(mx, 16)); mx = fmaxf(mx, __shfl_xor(mx, 32));
                const float mnew = fmaxf(mrun[qt], mx);
                const float alpha = __builtin_amdgcn_exp2f(mrun[qt] - mnew);
                mrun[qt] = mnew;
                lrun[qt] = lrun[qt] * alpha;
#pragma unroll
                for (int dt = 0; dt < 8; ++dt) O[qt][dt] = O[qt][dt] * alpha;
            }
            const float mnew = mrun[qt];
            float ls = 0.f;
#pragma unroll
            for (int kt = 0; kt < 4; ++kt)
#pragma unroll
                for (int j = 0; j < 4; ++j) { const float p = __builtin_amdgcn_exp2f(s[kt][qt][j] - mnew); s[kt][qt][j] = p; ls += p; }
            lrun[qt] += ls;
#pragma unroll
            for (int kk = 0; kk < 2; ++kk) {
                u32x4 w; w.x = pg8::cvt_pk_bf16(s[2 * kk][qt][0], s[2 * kk][qt][1]); w.y = pg8::cvt_pk_bf16(s[2 * kk][qt][2], s[2 * kk][qt][3]);
                w.z = pg8::cvt_pk_bf16(s[2 * kk + 1][qt][0], s[2 * kk + 1][qt][1]); w.w = pg8::cvt_pk_bf16(s[2 * kk + 1][qt][2], s[2 * kk + 1][qt][3]);
                pb[qt][kk] = __builtin_bit_cast(bf16x8, w);
            }
        }
        if (!grpB) AT_PV(Kt + 8704);
        }
        rb = rbn;
        __syncthreads();
    }
#undef AT_PV
#undef AT_LOAD
#undef AT_STORE
    float inv[2];
#pragma unroll
    for (int qt = 0; qt < 2; ++qt) { float l = lrun[qt]; l += __shfl_xor(l, 16); l += __shfl_xor(l, 32); inv[qt] = 1.0f / l; }
    __syncthreads();
    if (sm == 1) {
#pragma unroll
        for (int qt = 0; qt < 2; ++qt)
#pragma unroll
            for (int dt = 0; dt < 8; ++dt)
#pragma unroll
                for (int j = 0; j < 4; ++j) XO[(qg * 64 + (qt * 8 + dt) * 4 + j) * 64 + lane] = O[qt][dt][j] * inv[qt];
    }
    __syncthreads();
    if (sm == 0) {
#pragma unroll
        for (int qt = 0; qt < 2; ++qt) {
            float ss = 0.f;
#pragma unroll
            for (int dt = 0; dt < 8; ++dt)
#pragma unroll
                for (int j = 0; j < 4; ++j) { const float o = O[qt][dt][j] * inv[qt] - lam * XO[(qg * 64 + (qt * 8 + dt) * 4 + j) * 64 + lane]; O[qt][dt][j] = o; ss += o * o; }
            ss += __shfl_xor(ss, 16); ss += __shfl_xor(ss, 32);
            const float r = (1.0f - LAM_INIT0) / sqrtf(ss * (1.0f / 128.0f) + RMS_EPS_F);
            bf16_t* rowp = CAT + (size_t)(qrow0 + qg * 32 + qt * 16 + fr) * 2048 + h * 128 + 4 * fq;
#pragma unroll
            for (int dt = 0; dt < 8; ++dt) {
                const f32x4 w4 = *(const f32x4*)(subln + dt * 16 + 4 * fq);
                u32x2 w; w.x = pk2(O[qt][dt][0] * r * w4[0], O[qt][dt][1] * r * w4[1]); w.y = pk2(O[qt][dt][2] * r * w4[2], O[qt][dt][3] * r * w4[3]);
                *(u32x2*)(rowp + dt * 16) = w;
            }
        }
    }
}

constexpr int SC_RAWQ = 0, SC_RAWLF = 16384, SC_RAWVT = 32768, SC_PREP = 63488, SC_PREP_SZ = 36864;
constexpr int SP_QI = 0, SP_QR = 8704, SP_KR = 17408, SP_KET = 26112, SP_DEC = 36352;
#define chunk_row0(ci) ((ci) < 8 ? (MLAT + b * CTXL + 32 * (dir ? 7 - (ci) : (ci))) : (b * SEQ + 32 * (dir ? 63 - ((ci) - 8) : ((ci) - 8))))
template <int G_, int DIR_>
__device__ __forceinline__ void scan_elem_t(unsigned char* lds, int ci, int k) {
    const int cur = ci & 1; const bool need_out = ci >= 8;
    const bf16_t* rawq = (const bf16_t*)(lds + SC_RAWQ + cur * 8192) + k;
    const _Float16* rawlf = (const _Float16*)(lds + SC_RAWLF + cur * 8192) + k;
    unsigned char* pb = lds + SC_PREP + cur * SC_PREP_SZ;
    bf16_t* QI = (bf16_t*)(pb + SP_QI) + k; bf16_t* QR = (bf16_t*)(pb + SP_QR) + k; bf16_t* KR = (bf16_t*)(pb + SP_KR) + k; bf16_t* KET = (bf16_t*)(pb + SP_KET); float* DEC = (float*)(pb + SP_DEC);
    float run = 0.f, ref = 0.f, cums[8], lfv[8];
#pragma unroll
    for (int p = 0; p < 32; ++p) {
        const int i = DIR_ ? 31 - p : p;
        const float x = (float)rawlf[i * 128];
        run += x;
        if ((p >> 3) == G_) { cums[p & 7] = run; lfv[p & 7] = x; }
        if (p == 15) ref = run;
    }
    const float tot = run;
    const float E1 = __expf(fminf(-ref, 80.f)), E2 = __expf(fminf(ref - tot, 80.f));
    float ket[8], ec[8];
#pragma unroll
    for (int e = 0; e < 8; ++e) { ket[e] = (1.0f - __expf(lfv[e])) * __expf(tot - cums[e]); ec[e] = __expf(cums[e]); }
    if (need_out) {
#pragma unroll
        for (int e = 0; e < 8; e += 2) {
            const int p0 = 8 * G_ + e, i0 = DIR_ ? 31 - p0 : p0, i1 = DIR_ ? i0 - 1 : i0 + 1;
            const float qa = bf2f(rawq[i0 * 128]) * ec[e], qb = bf2f(rawq[i1 * 128]) * ec[e + 1];
            const unsigned wi = pg8::cvt_pk_bf16(qa, qb), wr_ = pg8::cvt_pk_bf16(qa * E1, qb * E1), wk = pg8::cvt_pk_bf16(ket[e] * E2, ket[e + 1] * E2);
            QI[i0 * 136] = (bf16_t)(wi & 0xffffu); QI[i1 * 136] = (bf16_t)(wi >> 16);
            QR[i0 * 136] = (bf16_t)(wr_ & 0xffffu); QR[i1 * 136] = (bf16_t)(wr_ >> 16);
            KR[i0 * 136] = (bf16_t)(wk & 0xffffu); KR[i1 * 136] = (bf16_t)(wk >> 16);
        }
    }
    u32x4 wv;
    if (DIR_) { wv.x = pg8::cvt_pk_bf16(ket[7], ket[6]); wv.y = pg8::cvt_pk_bf16(ket[5], ket[4]); wv.z = pg8::cvt_pk_bf16(ket[3], ket[2]); wv.w = pg8::cvt_pk_bf16(ket[1], ket[0]); }
    else      { wv.x = pg8::cvt_pk_bf16(ket[0], ket[1]); wv.y = pg8::cvt_pk_bf16(ket[2], ket[3]); wv.z = pg8::cvt_pk_bf16(ket[4], ket[5]); wv.w = pg8::cvt_pk_bf16(ket[6], ket[7]); }
    const int i0 = DIR_ ? 24 - 8 * G_ : 8 * G_;
    *(u32x4*)(KET + k * 40 + i0) = wv;
    if (G_ == 0) DEC[k] = __expf(tot);
}
__device__ __forceinline__ void scan_elem(unsigned char* lds, int ci, int dir, int k, int g) {
    const int sel = __builtin_amdgcn_readfirstlane(g * 2 + dir);
    switch (sel) {
        case 0: scan_elem_t<0, 0>(lds, ci, k); break;
        case 1: scan_elem_t<0, 1>(lds, ci, k); break;
        case 2: scan_elem_t<1, 0>(lds, ci, k); break;
        case 3: scan_elem_t<1, 1>(lds, ci, k); break;
        case 4: scan_elem_t<2, 0>(lds, ci, k); break;
        case 5: scan_elem_t<2, 1>(lds, ci, k); break;
        case 6: scan_elem_t<3, 0>(lds, ci, k); break;
        default: scan_elem_t<3, 1>(lds, ci, k); break;
    }
}
__device__ __forceinline__ void scan_mfma(unsigned char* lds, f32x4 (&S)[8], int ci, int vt3, int dir, int r0, bf16_t* Od, int h, int w, int fr, int fq) {
    const int cur = ci & 1; const bool need_out = ci >= 8;
    const bf16_t* rawvt = (const bf16_t*)(lds + SC_RAWVT + vt3 * 10240);
    unsigned char* pb = lds + SC_PREP + cur * SC_PREP_SZ;
    const bf16_t* QI = (const bf16_t*)(pb + SP_QI); const bf16_t* QR = (const bf16_t*)(pb + SP_QR); const bf16_t* KR = (const bf16_t*)(pb + SP_KR); const bf16_t* KET = (const bf16_t*)(pb + SP_KET); const float* DEC = (const float*)(pb + SP_DEC);
    if (need_out) {
        f32x4 sc[2][2];
#pragma unroll
        for (int st = 0; st < 2; ++st)
#pragma unroll
            for (int tt = 0; tt < 2; ++tt) {
                f32x4 z = {0.f, 0.f, 0.f, 0.f};
#pragma unroll
                for (int kk = 0; kk < 4; ++kk) {
                    const bf16x8 a = *(const bf16x8*)(KR + (st * 16 + fr) * 136 + kk * 32 + fq * 8);
                    const bf16x8 bq = *(const bf16x8*)(QR + (tt * 16 + fr) * 136 + kk * 32 + fq * 8);
                    z = __builtin_amdgcn_mfma_f32_16x16x32_bf16(a, bq, z, 0, 0, 0);
                }
#pragma unroll
                for (int j = 0; j < 4; ++j) { const int s_ = st * 16 + 4 * fq + j, t_ = tt * 16 + fr; const bool ok = dir ? (s_ >= t_) : (s_ <= t_); z[j] = ok ? z[j] : 0.f; }
                sc[st][tt] = z;
            }
        bf16x8 Sb[4];
#pragma unroll
        for (int kk = 0; kk < 4; ++kk) {
            u32x4 wv; wv.x = pg8::cvt_pk_bf16(S[2 * kk][0], S[2 * kk][1]); wv.y = pg8::cvt_pk_bf16(S[2 * kk][2], S[2 * kk][3]);
            wv.z = pg8::cvt_pk_bf16(S[2 * kk + 1][0], S[2 * kk + 1][1]); wv.w = pg8::cvt_pk_bf16(S[2 * kk + 1][2], S[2 * kk + 1][3]);
            Sb[kk] = __builtin_bit_cast(bf16x8, wv);
        }
        const u32x2 vlo = *(const u32x2*)(rawvt + (16 * w + fr) * 40 + 4 * fq);
        const u32x2 vhi = *(const u32x2*)(rawvt + (16 * w + fr) * 40 + 16 + 4 * fq);
        u32x4 vw; vw.x = vlo.x; vw.y = vlo.y; vw.z = vhi.x; vw.w = vhi.y;
        const bf16x8 bv = __builtin_bit_cast(bf16x8, vw);
#pragma unroll
        for (int tt = 0; tt < 2; ++tt) {
            u32x4 pw; pw.x = pg8::cvt_pk_bf16(sc[0][tt][0], sc[0][tt][1]); pw.y = pg8::cvt_pk_bf16(sc[0][tt][2], sc[0][tt][3]);
            pw.z = pg8::cvt_pk_bf16(sc[1][tt][0], sc[1][tt][1]); pw.w = pg8::cvt_pk_bf16(sc[1][tt][2], sc[1][tt][3]);
            f32x4 o = {0.f, 0.f, 0.f, 0.f}, o2 = {0.f, 0.f, 0.f, 0.f};
            o = __builtin_amdgcn_mfma_f32_16x16x32_bf16(__builtin_bit_cast(bf16x8, pw), bv, o, 0, 0, 0);
#pragma unroll
            for (int kk = 0; kk < 4; ++kk) {
                const u32x2 alo = *(const u32x2*)(QI + (tt * 16 + fr) * 136 + kk * 32 + 4 * fq);
                const u32x2 ahi = *(const u32x2*)(QI + (tt * 16 + fr) * 136 + kk * 32 + 16 + 4 * fq);
                u32x4 aw; aw.x = alo.x; aw.y = alo.y; aw.z = ahi.x; aw.w = ahi.y;
                if (kk & 1) o2 = __builtin_amdgcn_mfma_f32_16x16x32_bf16(__builtin_bit_cast(bf16x8, aw), Sb[kk], o2, 0, 0, 0);
                else        o  = __builtin_amdgcn_mfma_f32_16x16x32_bf16(__builtin_bit_cast(bf16x8, aw), Sb[kk], o, 0, 0, 0);
            }
            o = o + o2;
#pragma unroll
            for (int j = 0; j < 4; ++j) Od[(size_t)(r0 + tt * 16 + 4 * fq + j) * DM + h * 128 + 16 * w + fr] = (bf16_t)f2bf(o[j]);
        }
    }
    const bf16x8 bvt = *(const bf16x8*)(rawvt + (16 * w + fr) * 40 + fq * 8);
#pragma unroll
    for (int i = 0; i < 8; ++i) {
        const f32x4 dec = *(const f32x4*)(DEC + 16 * i + 4 * fq);
        const bf16x8 a = *(const bf16x8*)(KET + (16 * i + fr) * 40 + fq * 8);
        S[i] = __builtin_amdgcn_mfma_f32_16x16x32_bf16(a, bvt, S[i] * dec, 0, 0, 0);
    }
}
__device__ __forceinline__ void scan_chain(unsigned char* lds, const bf16_t* Q1, const _Float16* LFd, const bf16_t* VT1, bf16_t* Od, int b, int h, int dir) {
    int tid_ = threadIdx.x; asm volatile("" : "+v"(tid_)); const int tid = tid_, lane = tid & 63, w = tid >> 6, fr = lane & 15, fq = lane >> 4;
    const int k = tid & 127, g = tid >> 7;
    f32x4 S[8];
#pragma unroll
    for (int i = 0; i < 8; ++i) S[i] = (f32x4){0.f, 0.f, 0.f, 0.f};
    u32x4 rq, rl, rv;
#define SC_LOAD(ci_) do { const int r_ = chunk_row0(ci_); \
        rq = *(const u32x4*)(Q1 + (size_t)(r_ + (tid >> 4)) * DM + h * 128 + (tid & 15) * 8); \
        rl = *(const u32x4*)(LFd + (size_t)(r_ + (tid >> 4)) * DM + h * 128 + (tid & 15) * 8); \
        rv = *(const u32x4*)(VT1 + (size_t)(h * 128 + (tid >> 2)) * MTOT + r_ + (tid & 3) * 8); } while (0)
#define SC_STORE(par_, v3_) do { \
        *(u32x4*)(lds + SC_RAWQ + (par_) * 8192 + (tid >> 4) * 256 + (tid & 15) * 16) = rq; \
        *(u32x4*)(lds + SC_RAWLF + (par_) * 8192 + (tid >> 4) * 256 + (tid & 15) * 16) = rl; \
        *(u32x4*)(lds + SC_RAWVT + (v3_) * 10240 + (tid >> 2) * 80 + (tid & 3) * 16) = rv; } while (0)
    SC_LOAD(0); SC_STORE(0, 0);
    SC_LOAD(1); SC_STORE(1, 1);
    __syncthreads();
    scan_elem(lds, 0, dir, k, g);
    __syncthreads();
    int v3 = 0;
    for (int ci = 0; ci < 72; ++ci) {
        const int r0 = chunk_row0(ci);
        if (ci + 2 < 72) SC_LOAD(ci + 2);
        scan_mfma(lds, S, ci, v3, dir, r0, Od, h, w, fr, fq);
        if (ci + 1 < 72) scan_elem(lds, ci + 1, dir, k, g);
        const int v3n = v3 == 0 ? 2 : v3 - 1;
        if (ci + 2 < 72) SC_STORE(ci & 1, v3n);
        v3 = v3 == 2 ? 0 : v3 + 1;
        __syncthreads();
    }
#undef SC_LOAD
#undef SC_STORE
}

#define LAS __attribute__((address_space(3)))
#define XB_TMO      128
#define XB_XCNT(j)  (256  + 64 * (j))
#define XB_XSUB(j)  (1280 + 64 * (j))
#define XB_XGEN(j)  (2304 + 64 * (j))
#define XB_TOP      3328
#define XB_TOPGEN   3392
#define XCD_BAR_WORDS 3456
#define XB_SPIN_CAP (1u << 18)

__device__ __forceinline__ unsigned xb_ld(unsigned* p)              { return __hip_atomic_load(p, __ATOMIC_RELAXED, __HIP_MEMORY_SCOPE_AGENT); }
__device__ __forceinline__ unsigned xb_add(unsigned* p, unsigned v) { return __hip_atomic_fetch_add(p, v, __ATOMIC_RELAXED, __HIP_MEMORY_SCOPE_AGENT); }
__device__ __forceinline__ unsigned xb_xcc_id() { return (unsigned)__builtin_amdgcn_s_getreg((3 << 11) | 20) & 0xFu; }
#define XB_SPIN(cond, bar) do { unsigned _sp = 0; while (cond) { __builtin_amdgcn_s_sleep(1); \
    if ((++_sp & 255u) == 0u) { if (xb_ld(&(bar)[XB_TMO])) break; if (_sp > XB_SPIN_CAP) { atomicAdd(&(bar)[XB_TMO], 1u); break; } } } } while (0)

struct XcdBarrier {
    unsigned* bar; unsigned x;
    volatile LAS unsigned* st;
};

__device__ __forceinline__ XcdBarrier xcd_barrier_post(unsigned* bar, volatile LAS unsigned* st) {
    XcdBarrier b; b.bar = bar; b.x = xb_xcc_id(); b.st = st;
    if (threadIdx.x == 0) (void)xb_add(&bar[XB_XCNT(b.x)], 1u);
    return b;
}
__device__ __forceinline__ void xcd_barrier_complete(unsigned* bar, unsigned x, unsigned& nloc, unsigned& nx) {
    const unsigned G = gridDim.x * gridDim.y * gridDim.z;
    unsigned sum, cnt, mine, sp = 0u;
    for (;;) {
        sum = 0u; cnt = 0u; mine = 0u;
#pragma unroll
        for (unsigned j = 0; j < 16; ++j) { const unsigned c = xb_ld(&bar[XB_XCNT(j)]); sum += c; cnt += (c > 0u) ? 1u : 0u; mine = (j == x) ? c : mine; }
        if (sum == G) break;
        __builtin_amdgcn_s_sleep(1);
        if ((++sp & 255u) == 0u) { if (xb_ld(&bar[XB_TMO])) break; if (sp > XB_SPIN_CAP) { atomicAdd(&bar[XB_TMO], 1u); break; } }
    }
    nloc = mine > 0u ? mine : 1u; nx = cnt > 0u ? cnt : 1u;
}

__device__ __forceinline__ void xcd_barrier(const XcdBarrier& b) {
    asm volatile("s_waitcnt vmcnt(0)" ::: "memory");
    __syncthreads();
    if (threadIdx.x == 0) {
        unsigned* bar = b.bar;
        __builtin_amdgcn_s_waitcnt(0);
        unsigned nloc = b.st[0], nx = b.st[1];
        if (nloc == 0u) { xcd_barrier_complete(bar, b.x, nloc, nx); b.st[0] = nloc; b.st[1] = nx; }
        const unsigned old = xb_add(&bar[XB_XSUB(b.x)], 1u);
        const unsigned gen = old / nloc;
        if (old + 1u == (gen + 1u) * nloc) {
            __builtin_amdgcn_fence(__ATOMIC_RELEASE, "agent");
            asm volatile("s_waitcnt vmcnt(0)" ::: "memory");
            const unsigned og = xb_add(&bar[XB_TOP], 1u);
            const unsigned tg = og / nx;
            if (og + 1u == (tg + 1u) * nx) xb_add(&bar[XB_TOPGEN], 1u);
            else XB_SPIN(xb_ld(&bar[XB_TOPGEN]) == tg, bar);
            __builtin_amdgcn_fence(__ATOMIC_ACQUIRE, "agent");
            xb_add(&bar[XB_XGEN(b.x)], 1u);
            asm volatile("s_waitcnt vmcnt(0)" ::: "memory");
        } else {
            XB_SPIN(xb_ld(&bar[XB_XGEN(b.x)]) == gen, bar);
            __builtin_amdgcn_fence(__ATOMIC_ACQUIRE, "agent");
            asm volatile("s_waitcnt vmcnt(0)" ::: "memory");
        }
    }
    __syncthreads();
}

__global__ void __launch_bounds__(512, 2) hybrid_fwd(Args args) {
    extern __shared__ __attribute__((aligned(16))) unsigned char lds[];
    cg::grid_group grid = cg::this_grid();
    const int tid = threadIdx.x, lane = tid & 63, wave = __builtin_amdgcn_readfirstlane(tid >> 6);
    const int G = gridDim.x, bid = blockIdx.x;
    const int gw = bid * 8 + wave, NGW = G * 8;
    unsigned char* ws = args.ws;
    PG8_LAS unsigned char* ldsg = (PG8_LAS unsigned char*)lds;

    const float* x = args.in[0]; const float* cvec = args.in[1]; const float* ctx = args.in[2]; const float* c_ctx = args.in[3];
    const float* mod_w = args.in[4]; const float* mod_b = args.in[5];
    const float* ln_mix_g = args.in[6]; const float* ln_mix_b = args.in[7]; const float* ln_ffn_g = args.in[8]; const float* ln_ffn_b = args.in[9];
    const float* even_w_in = args.in[10]; const float* even_w_out = args.in[11]; const float* diff_lambda = args.in[12]; const float* diff_subln = args.in[13];
    const float* hgrn_w_in = args.in[14]; const float* hgrn_w_out = args.in[15]; const float* hgrn_lb = args.in[16]; const float* hgrn_norm = args.in[17];
    const float* ffn_w_up = args.in[18]; const float* ffn_conv_w = args.in[19]; const float* ffn_conv_b = args.in[20]; const float* ffn_w_down = args.in[21];
    float* hlat = args.out;
    float* hctx = (float*)(ws + WS_HCTX);
    float* modv = (float*)(ws + WS_MODV);
    float* rope = (float*)(ws + WS_ROPE);
    bf16_t* U = (bf16_t*)(ws + WS_U);
    unsigned* ctl = (unsigned*)(ws + WS_CTL);
    if (tid < 64) ((volatile LAS unsigned*)((LAS unsigned char*)lds + LDS_MISC))[tid] = 0u;
    __syncthreads();
    const XcdBarrier xbar = xcd_barrier_post(ctl + 1024, (volatile LAS unsigned*)((LAS unsigned char*)lds + LDS_MISC + 32));
#define GRID_BAR() xcd_barrier(xbar)

    for (int rep = 0; rep < (PROBE == 3 ? 2 : 1); ++rep) {
        if (bid == 0) {
            for (int e = tid; e < 1024; e += 512) {
                const int pos = e >> 4, i = e & 15;
                const float inv = 1.0f / powf(10000.0f, (float)(2 * i) / 32.0f);
                const float ang = (float)pos * inv;
                rope[e] = cosf(ang); rope[1024 + e] = sinf(ang);
            }
        }
        {
            float* sl = (float*)lds;
            float* red = (float*)(lds + 81920);
            for (int e = tid; e < 9 * DM; e += 512) { const int r = e >> 11, kk = e & 2047; const float v = r < 8 ? cvec[r * DM + kk] : c_ctx[kk]; sl[e] = silu_f(v); }
            __syncthreads();
            const int cg4 = tid & 7, kg = tid >> 3;
            float* red2 = (float*)(lds + 81920);
            for (int it = bid; it < 768; it += G) {
                const int l = it / 384, n0 = (it % 384) * 32;
                const float* wp = mod_w + (size_t)l * DM * NMOD + (size_t)(kg * 32) * NMOD + n0 + cg4 * 4;
                f32x4 a[9];
#pragma unroll
                for (int r = 0; r < 9; ++r) a[r] = (f32x4){0.f, 0.f, 0.f, 0.f};
#pragma unroll 8
                for (int kk = 0; kk < 32; ++kk) {
                    const f32x4 wv = *(const f32x4*)(wp + (size_t)kk * NMOD);
#pragma unroll
                    for (int r = 0; r < 9; ++r) a[r] += wv * sl[r * DM + kg * 32 + kk];
                }
#pragma unroll
                for (int r = 0; r < 9; ++r)
#pragma unroll
                    for (int j = 0; j < 4; ++j) { float t = a[r][j]; t += __shfl_xor(t, 8); t += __shfl_xor(t, 16); t += __shfl_xor(t, 32); a[r][j] = t; }
                if (lane < 8) {
#pragma unroll
                    for (int r = 0; r < 9; ++r) *(f32x4*)(red2 + (wave * 9 + r) * 32 + lane * 4) = a[r];
                }
                __syncthreads();
                if (tid < 288) {
                    const int r = tid >> 5, c2 = tid & 31; float s = 0.f;
#pragma unroll
                    for (int q2 = 0; q2 < 8; ++q2) s += red2[(q2 * 9 + r) * 32 + c2];
                    modv[(size_t)(l * 9 + r) * NMOD + n0 + c2] = s + mod_b[l * NMOD + n0 + c2];
                }
                __syncthreads();
            }
        }
        {
            bf16_t* D2 = (bf16_t*)(ws + WS_D2);
            for (size_t e = (size_t)bid * 512 + tid; e < (size_t)2048 * 512; e += (size_t)G * 512) {
                const int kq = (int)(e >> 9), n0 = (int)(e & 511) * 8;
                float v[8];
#pragma unroll
                for (int j = 0; j < 8; ++j) { const int n = n0 + j; const int mm = (kq * (n & 2047)) & 2047; const float a = (float)mm * (1.0f / 1024.0f); v[j] = n < 2048 ? cospif(a) : -sinpif(a); }
                u32x4 w; w.x = pk2(v[0], v[1]); w.y = pk2(v[2], v[3]); w.z = pk2(v[4], v[5]); w.w = pk2(v[6], v[7]);
                *(u32x4*)(D2 + (size_t)kq * 4096 + n0) = w;
            }
            bf16_t* D2C = (bf16_t*)(ws + WS_D2C);
            for (int e = bid * 512 + tid; e < 256 * 64; e += G * 512) {
                const int kq = e >> 6, n0 = (e & 63) * 8;
                float v[8];
#pragma unroll
                for (int j = 0; j < 8; ++j) { const int n = n0 + j; const int mm = (kq * (n & 255)) & 255; const float a = (float)mm * (1.0f / 128.0f); v[j] = n < 256 ? cospif(a) : -sinpif(a); }
                u32x4 w; w.x = pk2(v[0], v[1]); w.y = pk2(v[2], v[3]); w.z = pk2(v[4], v[5]); w.w = pk2(v[6], v[7]);
                *(u32x4*)(D2C + (size_t)kq * 512 + n0) = w;
            }
        }
        __syncthreads();
        {
            float* wt = (float*)lds;
            float* tab = (float*)(lds + 64 * 129 * 4);
            bf16_t* W0VF = (bf16_t*)(ws + WS_W0VF);
            for (int it = bid; it < 128; it += G) {
                const int kb = it >> 2, gq = it & 3;
                __syncthreads();
                if (tid < 128) tab[tid] = cospif((float)tid * (1.0f / 64.0f));
                for (int e = tid; e < 64 * 128; e += 512) { const int kk = e >> 7, c = e & 127; wt[kk * 129 + c] = even_w_in[(size_t)(kb * 64 + kk) * 5120 + 4608 + gq * 128 + c]; }
                __syncthreads();
                const int kk = tid & 63, mg = tid >> 6;
                for (int mi = 0; mi < 16; ++mi) {
                    const int mm = mg * 16 + mi;
                    float sa = 0.f, sb = 0.f;
#pragma unroll 8
                    for (int c = 0; c < 128; ++c) { const float wv = wt[kk * 129 + c]; const int ph = (c * mm) & 127; sa += wv * tab[ph]; sb += wv * tab[(ph + 96) & 127]; }
                    W0VF[(size_t)(1536 + gq * 128 + mm) * DM + kb * 64 + kk] = (bf16_t)f2bf(sa);
                    W0VF[(size_t)(2048 + gq * 128 + mm) * DM + kb * 64 + kk] = (bf16_t)f2bf(sb);
                }
            }
        }
        __syncthreads();
        {
            float* scr = (float*)(lds + wave * 16384);
            int base = 0;
#define RUNJOB(W_, ldw_, K_, ncols_, col0_, WT_, mode_, drow_) do { const TJob jb{W_, ldw_, K_, ncols_, col0_, WT_, mode_}; const int ni = tjob_items(jb); \
                const int first = ((gw - base) % NGW + NGW) % NGW; for (int it = first; it < ni; it += NGW) tjob_run(jb, drow_, it, scr, lane); base += ni; } while (0)
            RUNJOB(even_w_in, 5120, DM, 3072, 0, (bf16_t*)(ws + WS_W0QK), 0, 0);
            RUNJOB(even_w_in, 5120, DM, 1536, 3072, (bf16_t*)(ws + WS_W0VF), 0, 0);
            RUNJOB(even_w_out, DM, DM, DM, 0, (bf16_t*)(ws + WS_W0OUT), 0, 0);
            RUNJOB(hgrn_w_in, 10240, DM, 6144, 0, (bf16_t*)(ws + WS_W1A), 0, 0);
            RUNJOB(hgrn_w_in, 10240, DM, DM, 6144, (bf16_t*)(ws + WS_W1V), 0, 0);
            RUNJOB(hgrn_w_in, 10240, DM, DM, 8192, (bf16_t*)(ws + WS_W1A), 0, 6144);
            RUNJOB(hgrn_w_out, DM, DM, DM, 0, (bf16_t*)(ws + WS_W1OUT), 0, 0);
            RUNJOB(ffn_w_up, 2 * DFF, DM, 2 * DFF, 0, (bf16_t*)(ws + WS_WUP), 1, 0);
            RUNJOB(ffn_w_up + (size_t)DM * 2 * DFF, 2 * DFF, DM, 2 * DFF, 0, (bf16_t*)(ws + WS_WUP + 43 * MiB), 1, 0);
            RUNJOB(ffn_w_down, DM, DFF, DM, 0, (bf16_t*)(ws + WS_WDN), 0, 0);
            RUNJOB(ffn_w_down + (size_t)DFF * DM, DM, DFF, DM, 0, (bf16_t*)(ws + WS_WDN + 21 * MiB + 512 * 1024), 0, 0);
#undef RUNJOB
        }
    }
    grid.sync();

    for (int r = gw; r < MTOT; r += NGW) {
        const bool lat = r < MLAT;
        const float* zr = lat ? x + (size_t)r * DM : ctx + (size_t)(r - MLAT) * DM;
        const float* mrow = modv + (size_t)(0 * 9 + (lat ? (r >> 11) : 8)) * NMOD;
        row_op(zr, nullptr, nullptr, nullptr, false, mrow + 0 * DM, mrow + 1 * DM, U + (size_t)r * DM, lane);
    }
    GRID_BAR();

    {
        pg8::Gemm g1{U, (const bf16_t*)(ws + WS_W0QK), MTOT, 3072, DM}; pg8::StaticOrder S1; S1.init(MTOT, 3072, G, bid);
        EpiQK E1{(bf16_t*)(ws + R_QK), rope};
        pg8::gemm_phase<EpiQK, pg8::StaticOrder, GEMM_ALIGN, GEMM_SP2>(ldsg, g1, S1, E1);
        pg8::Gemm g2{(const bf16_t*)(ws + WS_W0VF), U, 2560, MTOT, DM}; pg8::StaticOrder S2; S2.init(2560, MTOT, G, (bid + 128) % G);
        EpiT E2{(bf16_t*)(ws + R_VT0), (bf16_t*)(ws + R_FTL), (bf16_t*)(ws + R_FTC), 0};
        pg8::gemm_phase<EpiT, pg8::StaticOrder, GEMM_ALIGN, GEMM_SP2>(ldsg, g2, S2, E2);
    }
    GRID_BAR();

    {
        pg8::Gemm gf{(const bf16_t*)(ws + WS_D2), (const bf16_t*)(ws + R_FTL), 2048, 4096, 4096}; pg8::StaticOrder Sf; Sf.init(2048, 4096, G, bid);
        EpiFour Ef{(bf16_t*)(ws + R_CAT), 0, SEQ, 1.0f / 512.0f};
        pg8::gemm_phase<EpiFour, pg8::StaticOrder, GEMM_ALIGN, GEMM_SP2>(ldsg, gf, Sf, Ef);
        pg8::Gemm gc{(const bf16_t*)(ws + WS_D2C), (const bf16_t*)(ws + R_FTC), 256, 4096, 512}; pg8::StaticOrder Sc; Sc.init(256, 4096, G, (bid + G - 128) % G);
        EpiFour Ec{(bf16_t*)(ws + R_CAT), MLAT, CTXL, 0.005524271728019903f};
        pg8::gemm_phase<EpiFour, pg8::StaticOrder, GEMM_ALIGN, GEMM_SP2>(ldsg, gc, Sc, Ec);
        float lam;
        {
            const float d01 = wave_sum(diff_lambda[lane] * diff_lambda[64 + lane]);
            const float d23 = wave_sum(diff_lambda[128 + lane] * diff_lambda[192 + lane]);
            lam = expf(d01) - expf(d23) + LAM_INIT0;
        }
        volatile int* qslot = (volatile int*)(lds + LDS_MISC);
        const int xq0 = (int)(xbar.x & 7u);
        for (int dq = 0; dq < 8; ++dq) {
        const int xq = (xq0 + dq) & 7;
        for (;;) {
            __syncthreads();
            if (tid == 0) *qslot = (int)atomicAdd(ctl + 64 + 64 * xq, 1u);
            __syncthreads();
            const int idx = *qslot;
            if (idx >= 216) break;
            int unit;
            if (idx < 192) unit = (xq * 12 + (idx >> 4)) * 16 + (idx & 15);
            else unit = 1536 + (xq * 12 + ((idx - 192) >> 1)) * 2 + ((idx - 192) & 1);
            attn_unit(lds, (const bf16_t*)(ws + R_QK), (const bf16_t*)(ws + R_VT0), (bf16_t*)(ws + R_CAT), diff_subln, lam, unit);
        }
        }
    }
    GRID_BAR();

    {
        pg8::Gemm g{(const bf16_t*)(ws + R_CAT), (const bf16_t*)(ws + WS_W0OUT), MTOT, DM, DM}; pg8::StaticOrder S; S.init(MTOT, DM, G, bid);
        EpiResid E{(bf16_t*)(ws + R_MB), modv + 0 * 9 * NMOD + 2 * DM};
        pg8::gemm_phase<EpiResid, pg8::StaticOrder, GEMM_ALIGN, GEMM_SP2>(ldsg, g, S, E);
    }
    GRID_BAR();

#define HROW(r) ((r) < MLAT ? hlat + (size_t)(r) * DM : hctx + (size_t)((r) - MLAT) * DM)
    { f32x4 gpre[8], bpre[8];
#pragma unroll
    for (int j = 0; j < 8; ++j) { gpre[j] = *((const f32x4*)ln_mix_g + lane + 64 * j); bpre[j] = *((const f32x4*)ln_mix_b + lane + 64 * j); }
    for (int r = gw; r < MTOT; r += NGW) {
        const float* mrow = modv + (size_t)(0 * 9 + (r < MLAT ? (r >> 11) : 8)) * NMOD;
        row_op(r < MLAT ? x + (size_t)r * DM : ctx + (size_t)(r - MLAT) * DM, HROW(r), ln_mix_g, ln_mix_b, true, mrow + 3 * DM, mrow + 4 * DM, U + (size_t)r * DM, lane, (const bf16_t*)(ws + R_MB) + (size_t)r * DM, gpre, bpre);
    }
    }
    GRID_BAR();

#define FFN_PHASES(L, MROWS) \
    { \
        pg8::Gemm g{U, (const bf16_t*)(ws + WS_WUP + (size_t)(L) * 43 * MiB), (MROWS), 2 * DFF, DM}; pg8::StaticOrder S; S.init((MROWS), 2 * DFF, G, bid); \
        EpiUpFused E{(bf16_t*)(ws + R_A1), (float*)(ws + R_EDGE), (float*)(ws + R_EDGE + 4 * MiB), (float*)(ws + R_EDGE + 8 * MiB), ffn_conv_w + (size_t)(L) * 3 * DFF, ffn_conv_b + (size_t)(L) * DFF, (float*)(lds + LDS_MISC + 1024)}; \
        pg8::gemm_phase<EpiUpFused, pg8::StaticOrder, true, GEMM_SP2>(ldsg, g, S, E); \
    } \
    GRID_BAR(); \
    { \
        bf16_t* HID = (bf16_t*)(ws + R_A1); const float* EA = (const float*)(ws + R_EDGE); const float* EP = (const float*)(ws + R_EDGE + 4 * MiB); const float* EV = (const float*)(ws + R_EDGE + 8 * MiB); \
        const float* cw = ffn_conv_w + (size_t)(L) * 3 * DFF; \
        const int nedge = ((MROWS) / 256) * 2 * DFF; \
        for (int it = bid * 512 + tid; it < nedge; it += G * 512) { \
            const int c = it % DFF, pe = it / DFF, pm = pe >> 1, e = pe & 1; \
            const bool lat = pm < 64; \
            float nb = 0.f; \
            if (e == 0) { if (lat && (pm & 7) != 0) nb = EA[(size_t)((pm - 1) * 2 + 1) * DFF + c]; } \
            else { if (lat && (pm & 7) != 7) nb = EA[(size_t)((pm + 1) * 2 + 0) * DFF + c]; } \
            const float cv = EP[(size_t)pe * DFF + c] + nb * cw[(e ? 2 * DFF : 0) + c]; \
            HID[(size_t)(pm * 256 + (e ? 255 : 0)) * DFF + c] = (bf16_t)f2bf(gelu_f(cv) * EV[(size_t)pe * DFF + c]); \
        } \
    } \
    GRID_BAR(); \
    { \
        pg8::Gemm g{(const bf16_t*)(ws + R_A1), (const bf16_t*)(ws + WS_WDN + (size_t)(L) * (21 * MiB + 512 * 1024)), (MROWS), DM, DFF}; pg8::StaticOrder S; S.init((MROWS), DM, G, bid); \
        EpiResid E{(bf16_t*)(ws + R_MB), modv + (size_t)(L) * 9 * NMOD + 5 * DM}; \
        pg8::gemm_phase<EpiResid, pg8::StaticOrder, GEMM_ALIGN, GEMM_SP2>(ldsg, g, S, E); \
    } \
    GRID_BAR();

    FFN_PHASES(0, MTOT)

    { f32x4 gpre[8], bpre[8];
#pragma unroll
    for (int j = 0; j < 8; ++j) { gpre[j] = *((const f32x4*)ln_ffn_g + lane + 64 * j); bpre[j] = *((const f32x4*)ln_ffn_b + lane + 64 * j); }
    for (int r = gw; r < MTOT; r += NGW) {
        const float* mrow = modv + (size_t)(1 * 9 + (r < MLAT ? (r >> 11) : 8)) * NMOD;
        row_op(HROW(r), HROW(r), ln_ffn_g, ln_ffn_b, true, mrow + 0 * DM, mrow + 1 * DM, U + (size_t)r * DM, lane, (const bf16_t*)(ws + R_MB) + (size_t)r * DM, gpre, bpre);
    }
    }
    GRID_BAR();

    {
        pg8::Gemm g1{U, (const bf16_t*)(ws + WS_W1A), MLAT, 8192, DM}; pg8::StaticOrder S1; S1.init(MLAT, 8192, G, bid);
        EpiH1 E1{(bf16_t*)(ws + R_Q1), (_Float16*)(ws + R_LF), (bf16_t*)(ws + R_G1), hgrn_lb, 0, 0};
        pg8::gemm_phase<EpiH1, pg8::StaticOrder, GEMM_ALIGN, GEMM_SP2>(ldsg, g1, S1, E1);
        pg8::Gemm g1c{U + (size_t)MLAT * DM, (const bf16_t*)(ws + WS_W1A) + (size_t)2048 * DM, MCTX, 4096, DM}; pg8::StaticOrder S1c; S1c.init(MCTX, 4096, G, bid);
        EpiH1 E1c{(bf16_t*)(ws + R_Q1), (_Float16*)(ws + R_LF), (bf16_t*)(ws + R_G1), hgrn_lb, MLAT, 8};
        pg8::gemm_phase<EpiH1, pg8::StaticOrder, GEMM_ALIGN, GEMM_SP2>(ldsg, g1c, S1c, E1c);
        pg8::Gemm g2{(const bf16_t*)(ws + WS_W1V), U, 2048, MTOT, DM}; pg8::StaticOrder S2; S2.init(2048, MTOT, G, (bid + 128) % G);
        EpiT E2{(bf16_t*)(ws + R_VT1), nullptr, nullptr, 1};
        pg8::gemm_phase<EpiT, pg8::StaticOrder, GEMM_ALIGN, GEMM_SP2>(ldsg, g2, S2, E2);
    }
    GRID_BAR();

    for (int rep = 0; rep < (PROBE == 2 ? 2 : 1); ++rep)
    for (int chain = bid; chain < 256; chain += G) {
        const int dir = chain & 1, bh = chain >> 1, b = bh >> 4, h = bh & 15;
        __syncthreads();
        scan_chain(lds, (const bf16_t*)(ws + R_Q1), (const _Float16*)(ws + R_LF) + (size_t)dir * MTOT * DM, (const bf16_t*)(ws + R_VT1),
                   dir ? (bf16_t*)(ws + R_OB) : U, b, h, dir);
    }
    GRID_BAR();

    {
        const bf16_t* OF = U; const bf16_t* OB = (const bf16_t*)(ws + R_OB); const bf16_t* G1 = (const bf16_t*)(ws + R_G1); bf16_t* Y = (bf16_t*)(ws + R_Q1);
        float nw[32];
#pragma unroll
        for (int q8 = 0; q8 < 8; ++q8) { const f32x4 t4 = *(const f32x4*)(hgrn_norm + (lane & 3) * 32 + q8 * 4); nw[q8 * 4 + 0] = t4[0]; nw[q8 * 4 + 1] = t4[1]; nw[q8 * 4 + 2] = t4[2]; nw[q8 * 4 + 3] = t4[3]; }
        for (int r = gw; r < MLAT; r += NGW) {
            const size_t off = (size_t)r * DM + lane * 32;
            float o[32]; float ss = 0.f;
#pragma unroll
            for (int q4 = 0; q4 < 4; ++q4) {
                const u32x4 a = *(const u32x4*)(OF + off + q4 * 8), bq = *(const u32x4*)(OB + off + q4 * 8);
#pragma unroll
                for (int e = 0; e < 4; ++e) {
                    const float lo = bf2f((unsigned short)(a[e] & 0xffffu)) + bf2f((unsigned short)(bq[e] & 0xffffu));
                    const float hi = bf2f((unsigned short)(a[e] >> 16)) + bf2f((unsigned short)(bq[e] >> 16));
                    o[q4 * 8 + 2 * e] = lo; o[q4 * 8 + 2 * e + 1] = hi; ss += lo * lo + hi * hi;
                }
            }
            ss += __shfl_xor(ss, 1); ss += __shfl_xor(ss, 2);
            const float rs = 1.0f / sqrtf(ss * (1.0f / 128.0f) + RMS_EPS_F);
            const int d0 = (lane & 3) * 32;
#pragma unroll
            for (int q4 = 0; q4 < 4; ++q4) {
                const u32x4 gg = *(const u32x4*)(G1 + off + q4 * 8);
                u32x4 ow;
#pragma unroll
                for (int e = 0; e < 4; ++e) {
                    const float lo = o[q4 * 8 + 2 * e] * rs * nw[q4 * 8 + 2 * e] * bf2f((unsigned short)(gg[e] & 0xffffu));
                    const float hi = o[q4 * 8 + 2 * e + 1] * rs * nw[q4 * 8 + 2 * e + 1] * bf2f((unsigned short)(gg[e] >> 16));
                    ow[e] = pk2(lo, hi);
                }
                *(u32x4*)(Y + off + q4 * 8) = ow;
            }
        }
    }
    GRID_BAR();

    {
        pg8::Gemm g{(const bf16_t*)(ws + R_Q1), (const bf16_t*)(ws + WS_W1OUT), MLAT, DM, DM}; pg8::StaticOrder S; S.init(MLAT, DM, G, bid);
        EpiResid E{(bf16_t*)(ws + R_MB), modv + (size_t)1 * 9 * NMOD + 2 * DM};
        pg8::gemm_phase<EpiResid, pg8::StaticOrder, GEMM_ALIGN, GEMM_SP2>(ldsg, g, S, E);
    }
    GRID_BAR();

    { f32x4 gpre[8], bpre[8];
#pragma unroll
    for (int j = 0; j < 8; ++j) { gpre[j] = *((const f32x4*)(ln_mix_g + DM) + lane + 64 * j); bpre[j] = *((const f32x4*)(ln_mix_b + DM) + lane + 64 * j); }
    for (int r = gw; r < MLAT; r += NGW) {
        const float* mrow = modv + (size_t)(1 * 9 + (r >> 11)) * NMOD;
        row_op(HROW(r), HROW(r), ln_mix_g + DM, ln_mix_b + DM, true, mrow + 3 * DM, mrow + 4 * DM, U + (size_t)r * DM, lane, (const bf16_t*)(ws + R_MB) + (size_t)r * DM, gpre, bpre);
    }
    }
    GRID_BAR();

    FFN_PHASES(1, MLAT)

    f32x4 gpre[8], bpre[8];
#pragma unroll
    for (int j = 0; j < 8; ++j) { gpre[j] = *((const f32x4*)(ln_ffn_g + DM) + lane + 64 * j); bpre[j] = *((const f32x4*)(ln_ffn_b + DM) + lane + 64 * j); }
    for (int r = gw; r < MLAT; r += NGW)
        row_op(HROW(r), HROW(r), ln_ffn_g + DM, ln_ffn_b + DM, true, nullptr, nullptr, nullptr, lane, (const bf16_t*)(ws + R_MB) + (size_t)r * DM, gpre, bpre);
}

extern "C" void kernel_launch(void* const* d_in, const int* in_sizes, int n_in, void* d_out, int out_size, void* d_ws, size_t ws_size, hipStream_t stream) {
    static int grid = 0;
    if (grid == 0) {
        if (n_in != 22 || ws_size < WS_END) { fprintf(stderr, "kernel_launch: unexpected n_in %d / ws_size %zu\n", n_in, ws_size); grid = -1; return; }
        int dev = 0, cus = 0, per_cu = 0;
        (void)hipGetDevice(&dev);
        (void)hipDeviceGetAttribute(&cus, hipDeviceAttributeMultiprocessorCount, dev);
        if (hipFuncSetAttribute((const void*)hybrid_fwd, hipFuncAttributeMaxDynamicSharedMemorySize, LDS_BYTES) != hipSuccess) { fprintf(stderr, "kernel_launch: hipFuncSetAttribute failed\n"); grid = -1; return; }
        if (hipOccupancyMaxActiveBlocksPerMultiprocessor(&per_cu, (const void*)hybrid_fwd, 512, LDS_BYTES) != hipSuccess || per_cu < 1) { fprintf(stderr, "kernel_launch: occupancy query gives %d\n", per_cu); per_cu = 1; }
        (void)hipGetLastError();
        grid = cus * 1;
    }
    if (grid < 0) return;
    (void)hipMemsetAsync((char*)d_ws + WS_CTL, 0, 65536, stream);
    Args a{};
    for (int i = 0; i < 22; ++i) a.in[i] = (const float*)d_in[i];
    a.out = (float*)d_out; a.ws = (unsigned char*)d_ws; a.dbg = 0; a.pad = 0;
    void* kargs[] = {&a};
    hipError_t e = hipLaunchCooperativeKernel((const void*)hybrid_fwd, dim3(grid), dim3(512), kargs, LDS_BYTES, stream);
    if (e != hipSuccess) fprintf(stderr, "kernel_launch: cooperative launch failed: %s (grid %d)\n", hipGetErrorString(e), grid);
}
```

```cpp
#include <hip/hip_runtime.h>
#include <hip/hip_cooperative_groups.h>
#include <cstdio>
#include <cstdint>
namespace cg = cooperative_groups;
namespace pg8 {
#define PG8_LAS __attribute__((address_space(3)))
typedef unsigned short bf16_t;
typedef short bf16x8 __attribute__((ext_vector_type(8)));
typedef float f32x4 __attribute__((ext_vector_type(4)));
typedef unsigned u32x4 __attribute__((ext_vector_type(4)));
constexpr int BM = 256, BK = 64, HALF = 128, HTB = HALF * BK * 2  , STAGE_BYTES = 8 * HTB, NXCD = 8, WGM = 8;

__host__ __device__ __forceinline__ int lds_byte(int r, int c) { const int st = (r >> 4) * 2 + (c >> 5), rr = r & 15, cc = c & 31, ob = rr * 64 + cc * 2; return st * 1024 + (ob ^ (((ob >> 9) & 1) << 5)); }
__host__ __device__ __forceinline__ void stage_rc(int b, int& R, int& C) { const int st = b / 1024, sb = b % 1024, swz = sb ^ (((sb >> 9) & 1) << 5); R = (st >> 1) * 16 + swz / 64; C = (st & 1) * 32 + (swz % 64) / 2; }
__host__ __device__ __forceinline__ int perm32(int rho) { const int n = rho >> 4, i = rho & 15; return 8 * (i >> 2) + 4 * n + (i & 3); }

struct Unit { int pm, pn; };
struct Gemm { const bf16_t* A; const bf16_t* Bt; int M, N, K; };

struct StaticOrder {
    int nM, nN, nwg, G, c;
    __host__ __device__ void init(int M, int N, int G_, int c_) { nM = M / BM; nN = N / BM; nwg = nM * nN; G = G_; c = c_; }
    __host__ __device__ bool next(int i, Unit& u) const {
        const long L = (long)i * G + c; if (L >= nwg) return false;
        int wgid = (int)L; { const int q = nwg / NXCD, r = nwg % NXCD, xcd = wgid % NXCD, off = wgid / NXCD; wgid = (xcd < r ? xcd * (q + 1) : r * (q + 1) + (xcd - r) * q) + off; }
        const int nig = WGM * nN, gid = wgid / nig, fm = gid * WGM, gsz = (nM - fm) < WGM ? (nM - fm) : WGM;
        u.pm = fm + ((wgid % nig) % gsz); u.pn = (wgid % nig) / gsz; return true;
    }
    __device__ __forceinline__ void a_ready(const Unit&) const {}
    __device__ __forceinline__ void done(const Unit&) const {}
};
__device__ __forceinline__ unsigned cvt_pk_bf16(float lo, float hi) { unsigned r; asm volatile("v_cvt_pk_bf16_f32 %0, %1, %2" : "=v"(r) : "v"(lo), "v"(hi)); return r; }
typedef float f32x2 __attribute__((ext_vector_type(2)));
__device__ __forceinline__ f32x2 gelu_pk(f32x2 v) {
    const f32x2 av = __builtin_elementwise_abs(v), d = av * 0.2316418882f + 1.0f;
    f32x2 t; t.x = __builtin_amdgcn_rcpf(d.x); t.y = __builtin_amdgcn_rcpf(d.y);
    f32x2 q = t * 0.5307027145f + (-0.7265760135f); q = q * t + 0.7107068705f; q = q * t + (-0.142248368f); q = q * t + 0.127414796f; q = q * t;
    const f32x2 s = (v * v) * (-0.72134752044f);
    f32x2 e; e.x = __builtin_amdgcn_exp2f(s.x); e.y = __builtin_amdgcn_exp2f(s.y);
    const f32x2 m = v * (q * e), r = v - m;
    f32x2 o; o.x = v.x < 0.f ? m.x : r.x; o.y = v.y < 0.f ? m.y : r.y; return o;
}
template <class Epi, class Sched, bool ALIGN_EPI = false, bool SP2 = false>
__device__ __forceinline__ void gemm_phase(PG8_LAS unsigned char* lds, const Gemm g, const Sched& S, const Epi& E) {
    int tid_ = threadIdx.x; asm volatile("" : "+v"(tid_)); const int tid = tid_, wid = __builtin_amdgcn_readfirstlane(tid >> 6), lane = tid & 63, wr = wid >> 2, wc = wid & 3, fr = lane & 15, fq = lane >> 4;
    const int K = g.K, nt = K / BK;
    unsigned voffA[2], voffB[2];
#pragma unroll
    for (int i = 0; i < 2; ++i) { int R, C; stage_rc(tid * 16 + i * 8192, R, C); const int Rb = Epi::PERM ? ((R & ~31) + perm32(R & 31)) : R;
        voffA[i] = (unsigned)(R * K + C) * 2u; voffB[i] = (unsigned)(Rb * K + C) * 2u; }
    const size_t kstep = (size_t)(BK * 2);
    const size_t hstep = (size_t)HALF * K * 2;
    const size_t tstep = 2 * hstep;
    const unsigned ldsw = (unsigned)wid * 1024u;
    const int aoff = lds_byte(wr * 64 + fr, fq * 8), boff = lds_byte(wc * 32 + fr, fq * 8);
#define PG8_SA(b, h) (((b) * 2 + (h)) * HTB)
#define PG8_SB(b, h) ((4 + (b) * 2 + (h)) * HTB)
#define PG8_STAGE(bufoff, gbase, voff) do { _Pragma("unroll") for (int _i = 0; _i < 2; ++_i) \
        __builtin_amdgcn_global_load_lds((const unsigned*)((const char*)(gbase) + (voff)[_i]), (PG8_LAS unsigned*)(lds + (bufoff) + ldsw + _i * 8192), 16, 0, 0); } while (0)
#define PG8_LDA(dst, b, h) do { _Pragma("unroll") for (int m = 0; m < 4; ++m) _Pragma("unroll") for (int k = 0; k < 2; ++k) dst[m][k] = *(const PG8_LAS bf16x8*)(lds + PG8_SA(b, h) + aoff + m * 2048 + k * 1024); } while (0)
#define PG8_LDB(dst, b, h) do { _Pragma("unroll") for (int n = 0; n < 2; ++n) _Pragma("unroll") for (int k = 0; k < 2; ++k) dst[n][k] = *(const PG8_LAS bf16x8*)(lds + PG8_SB(b, h) + boff + n * 2048 + k * 1024); } while (0)
#define PG8_MMA(ai, bj, At, Bt) do { __builtin_amdgcn_s_setprio(1); _Pragma("unroll") for (int m = 0; m < 4; ++m) _Pragma("unroll") for (int n = 0; n < 2; ++n) _Pragma("unroll") for (int k = 0; k < 2; ++k) \
        acc[ai][bj][m][n] = __builtin_amdgcn_mfma_f32_16x16x32_bf16(Bt[n][k], At[m][k], acc[ai][bj][m][n], 0, 0, 0); __builtin_amdgcn_s_setprio(0); } while (0)
#define PG8_WAIT_V(n) asm volatile("s_waitcnt vmcnt(" #n ")" ::: "memory")
#define PG8_WAIT_L(n) asm volatile("s_waitcnt lgkmcnt(" #n ")" ::: "memory")
#define PG8_BAR __builtin_amdgcn_s_barrier()
#define PG8_SCHED __builtin_amdgcn_sched_barrier(0)
    Unit cur, nxt; int ui = 0;
    if (!S.next(0, cur)) return;
    f32x4 acc[2][2][4][2];
#pragma unroll
    for (int a = 0; a < 2; ++a)
#pragma unroll
        for (int b = 0; b < 2; ++b)
#pragma unroll
            for (int m = 0; m < 4; ++m)
#pragma unroll
                for (int n = 0; n < 2; ++n) acc[a][b][m][n] = (f32x4){0.f, 0.f, 0.f, 0.f};
    bf16x8 At[4][2], B0[2][2], B1[2][2];
    const char* cA = (const char*)g.A + (size_t)cur.pm * tstep; const char* cB = (const char*)g.Bt + (size_t)cur.pn * tstep;
    S.a_ready(cur);
    if constexpr (SP2) {
        PG8_STAGE(PG8_SB(0, 0), cB, voffB); PG8_STAGE(PG8_SB(0, 1), cB + hstep, voffB); PG8_STAGE(PG8_SA(0, 0), cA, voffA); PG8_STAGE(PG8_SA(0, 1), cA + hstep, voffA);
        if (wr == 1) PG8_BAR;
        PG8_WAIT_V(2); PG8_BAR;
        PG8_STAGE(PG8_SB(1, 0), cB + kstep, voffB); PG8_STAGE(PG8_SA(1, 0), cA + kstep, voffA); PG8_STAGE(PG8_SB(1, 1), cB + hstep + kstep, voffB);
        PG8_WAIT_V(6); PG8_BAR;
    } else {
        PG8_STAGE(PG8_SB(0, 0), cB, voffB); PG8_STAGE(PG8_SA(0, 0), cA, voffA); PG8_STAGE(PG8_SB(0, 1), cB + hstep, voffB); PG8_STAGE(PG8_SA(0, 1), cA + hstep, voffA);
        if (wr == 1) PG8_BAR;
        PG8_WAIT_V(4); PG8_BAR;
        PG8_STAGE(PG8_SB(1, 0), cB + kstep, voffB); PG8_STAGE(PG8_SA(1, 0), cA + kstep, voffA); PG8_STAGE(PG8_SB(1, 1), cB + hstep + kstep, voffB);
        PG8_WAIT_V(6); PG8_BAR;
    }
    for (;;) {
        const bool has_next = S.next(ui + 1, nxt);
        const char* nA = has_next ? (const char*)g.A + (size_t)nxt.pm * tstep : cA; const char* nB = has_next ? (const char*)g.Bt + (size_t)nxt.pn * tstep : cB;
        for (int t = 0; t < nt; t += 2) {
            const bool last = (t == nt - 2);
            const char* a1 = cA + (size_t)(t + 1) * kstep;
            const char* a2 = last ? nA : cA + (size_t)(t + 2) * kstep; const char* b2 = last ? nB : cB + (size_t)(t + 2) * kstep;
            const char* a3 = a2 + kstep; const char* b3 = b2 + kstep;
            if (last && has_next) S.a_ready(nxt);
            if constexpr (SP2) {
            PG8_LDB(B0, 0, 0); PG8_LDB(B1, 0, 1); PG8_SCHED; PG8_LDA(At, 0, 0); PG8_STAGE(PG8_SA(1, 1), a1 + hstep, voffA);
            PG8_WAIT_V(8); PG8_WAIT_L(0); PG8_BAR; PG8_MMA(0, 0, At, B0); PG8_MMA(0, 1, At, B1); PG8_BAR; PG8_SCHED;
            PG8_LDA(At, 0, 1); PG8_STAGE(PG8_SB(0, 0), b2, voffB); PG8_STAGE(PG8_SB(0, 1), b2 + hstep, voffB); PG8_STAGE(PG8_SA(0, 0), a2, voffA);
            PG8_WAIT_V(8); PG8_WAIT_L(0); PG8_BAR; PG8_MMA(1, 0, At, B0); PG8_MMA(1, 1, At, B1); PG8_BAR; PG8_SCHED;
            PG8_LDB(B0, 1, 0); PG8_LDB(B1, 1, 1); PG8_SCHED; PG8_LDA(At, 1, 0); PG8_STAGE(PG8_SA(0, 1), a2 + hstep, voffA);
            PG8_WAIT_V(8); PG8_WAIT_L(0); PG8_BAR; PG8_MMA(0, 0, At, B0); PG8_MMA(0, 1, At, B1); PG8_BAR; PG8_SCHED;
            PG8_LDA(At, 1, 1); PG8_STAGE(PG8_SB(1, 0), b3, voffB); PG8_STAGE(PG8_SB(1, 1), b3 + hstep, voffB); PG8_STAGE(PG8_SA(1, 0), a3, voffA);
            PG8_WAIT_V(8); PG8_WAIT_L(0); PG8_BAR; PG8_MMA(1, 0, At, B0); PG8_MMA(1, 1, At, B1); PG8_BAR; PG8_SCHED;
            } else {
            PG8_LDB(B0, 0, 0); PG8_SCHED; PG8_LDA(At, 0, 0); PG8_STAGE(PG8_SA(1, 1), a1 + hstep, voffA);
            PG8_WAIT_L(8); PG8_BAR; PG8_WAIT_L(0); PG8_MMA(0, 0, At, B0); PG8_BAR; PG8_SCHED;
            PG8_LDB(B1, 0, 1); PG8_STAGE(PG8_SB(0, 0), b2, voffB);
            PG8_BAR; PG8_WAIT_L(0); PG8_MMA(0, 1, At, B1); PG8_BAR;
            PG8_LDA(At, 0, 1); PG8_STAGE(PG8_SA(0, 0), a2, voffA);
            PG8_BAR; PG8_WAIT_L(0); PG8_MMA(1, 0, At, B0); PG8_BAR; PG8_SCHED;
            PG8_STAGE(PG8_SB(0, 1), b2 + hstep, voffB);
            PG8_WAIT_V(6); PG8_BAR; PG8_MMA(1, 1, At, B1); PG8_BAR;
            PG8_LDB(B0, 1, 0); PG8_SCHED; PG8_LDA(At, 1, 0); PG8_STAGE(PG8_SA(0, 1), a2 + hstep, voffA);
            PG8_WAIT_L(8); PG8_BAR; PG8_WAIT_L(0); PG8_MMA(0, 0, At, B0); PG8_BAR; PG8_SCHED;
            PG8_LDB(B1, 1, 1); PG8_STAGE(PG8_SB(1, 0), b3, voffB);
            PG8_BAR; PG8_WAIT_L(0); PG8_MMA(0, 1, At, B1); PG8_BAR;
            PG8_LDA(At, 1, 1); PG8_STAGE(PG8_SA(1, 0), a3, voffA);
            PG8_BAR; PG8_WAIT_L(0); PG8_MMA(1, 0, At, B0); PG8_BAR; PG8_SCHED;
            PG8_STAGE(PG8_SB(1, 1), b3 + hstep, voffB);
            PG8_WAIT_V(6); PG8_BAR; PG8_MMA(1, 1, At, B1); PG8_BAR;
            }
        }
        if constexpr (ALIGN_EPI) { if (wr == 0) PG8_BAR; }
        if constexpr (!Epi::AFTER_DRAIN) { E(acc, cur, wr, wc, fr, fq); S.done(cur); }
        if (!has_next) break;
#pragma unroll
        for (int a = 0; a < 2; ++a)
#pragma unroll
            for (int b = 0; b < 2; ++b)
#pragma unroll
                for (int m = 0; m < 4; ++m)
#pragma unroll
                    for (int n = 0; n < 2; ++n) acc[a][b][m][n] = (f32x4){0.f, 0.f, 0.f, 0.f};
        cur = nxt; cA = nA; cB = nB; ++ui;
        if constexpr (ALIGN_EPI) { if (wr == 1) PG8_BAR; }
    }
    PG8_WAIT_V(0);
    if constexpr (!ALIGN_EPI) { if (wr == 0) PG8_BAR; }
    PG8_BAR;
    if constexpr (Epi::AFTER_DRAIN) { E.fused(acc, cur, wr, wc, fr, fq, lds, wid, lane); S.done(cur); }
#undef PG8_SA
#undef PG8_SB
#undef PG8_STAGE
#undef PG8_LDA
#undef PG8_LDB
#undef PG8_MMA
#undef PG8_WAIT_V
#undef PG8_WAIT_L
#undef PG8_BAR
#undef PG8_SCHED
}
}

using pg8::bf16_t; using pg8::bf16x8; using pg8::f32x4; using pg8::u32x4; using pg8::Unit;
typedef _Float16 h16x8 __attribute__((ext_vector_type(8)));
typedef unsigned u32x2 __attribute__((ext_vector_type(2)));
#ifndef PROBE
#define PROBE 0
#endif
constexpr bool GEMM_ALIGN = true, GEMM_SP2 = true;
constexpr int DM = 2048, NBATCH = 8, SEQ = 2048, CTXL = 256, MLAT = NBATCH * SEQ, MCTX = NBATCH * CTXL, MTOT = MLAT + MCTX;
constexpr int DFF = 5504, NMOD = 6 * DM;
constexpr float ALPHA_F = 1.4142135623730951f;
constexpr float LN_EPS_F = 1e-6f, RMS_EPS_F = 1e-5f;
constexpr float LAM_INIT0 = 0.2f;
constexpr float QSCALE = 0.125f * 1.4426950408889634f;

constexpr size_t MiB = 1u << 20;
constexpr size_t WS_CTL = 0;
constexpr size_t WS_MODV = 1 * MiB;
constexpr size_t WS_ROPE = 2 * MiB;
constexpr size_t WS_W0QK = 4 * MiB;
constexpr size_t WS_W0VF = 16 * MiB;
constexpr size_t WS_W0OUT = 26 * MiB;
constexpr size_t WS_W1A = 34 * MiB;
constexpr size_t WS_W1V = 66 * MiB;
constexpr size_t WS_W1OUT = 74 * MiB;
constexpr size_t WS_WUP = 82 * MiB;
constexpr size_t WS_WDN = 168 * MiB;
constexpr size_t WS_D2 = 211 * MiB;
constexpr size_t WS_D2C = 227 * MiB;
constexpr size_t WS_HCTX = 228 * MiB;
constexpr size_t WS_U = 244 * MiB;
constexpr size_t WS_R = 316 * MiB;
constexpr size_t WS_END = 768 * MiB;
constexpr size_t R_QK = WS_R;
constexpr size_t R_VT0 = WS_R + 108 * MiB;
constexpr size_t R_FTL = WS_R + 162 * MiB;
constexpr size_t R_FTC = WS_R + 194 * MiB;
constexpr size_t R_CAT = WS_R + 198 * MiB;
constexpr size_t R_A1 = WS_R;
constexpr size_t R_V1 = WS_R + 194 * MiB;
constexpr size_t R_MB = WS_R + 272 * MiB;
constexpr size_t R_EDGE = WS_R + 390 * MiB;
constexpr size_t R_Q1 = WS_R;
constexpr size_t R_LF = WS_R + 72 * MiB;
constexpr size_t R_G1 = WS_R + 216 * MiB;
constexpr size_t R_VT1 = WS_R + 288 * MiB;
constexpr size_t R_OB = WS_R + 360 * MiB;

constexpr int LDS_BYTES = 152576;
constexpr int LDS_MISC = 147456;

struct Args {
    const float* in[22]; float* out; unsigned char* ws; int dbg; int pad;
};

__device__ __forceinline__ float bf2f(unsigned short v) { return __builtin_bit_cast(float, (unsigned)v << 16); }
__device__ __forceinline__ unsigned f2bf(float f) { return pg8::cvt_pk_bf16(f, f) & 0xffffu; }
__device__ __forceinline__ unsigned pk2(float lo, float hi) { return pg8::cvt_pk_bf16(lo, hi); }
__device__ __forceinline__ float wave_sum(float v) {
#pragma unroll
    for (int o = 1; o < 64; o <<= 1) v += __shfl_xor(v, o);
    return v;
}
__device__ __forceinline__ float silu_f(float x) { return x * __builtin_amdgcn_rcpf(1.0f + __expf(-x)); }
__device__ __forceinline__ float sigmoid_f(float x) { return __builtin_amdgcn_rcpf(1.0f + __expf(-x)); }
__device__ __forceinline__ float gelu_f(float v) {
    const float av = fabsf(v), t = __builtin_amdgcn_rcpf(av * 0.2316418882f + 1.0f);
    float q = t * 0.5307027145f + (-0.7265760135f); q = q * t + 0.7107068705f; q = q * t + (-0.142248368f); q = q * t + 0.127414796f; q = q * t;
    const float e = __builtin_amdgcn_exp2f((v * v) * (-0.72134752044f));
    const float m = v * (q * e);
    return v < 0.f ? m : v - m;
}

struct EpiQK {
    static constexpr bool PERM = true, AFTER_DRAIN = false;
    bf16_t* O; const float* rope;
    __device__ __forceinline__ void operator()(const f32x4 (&acc)[2][2][4][2], const Unit& u, int wr, int wc, int fr, int fq) const {
        const int row0 = u.pm * 256 + wr * 64 + fr;
        const int colt = u.pn * 256;
        const bool isq = colt < 1536;
        const float sc = isq ? QSCALE : 1.0f;
        const bool lat = (u.pm < 64);
        const int axis = wc & 1;
        const bool second = fq >= 2;
        const int i0 = 8 * (fq & 1);
#pragma unroll
        for (int ai = 0; ai < 2; ++ai)
#pragma unroll
            for (int m = 0; m < 4; ++m) {
                const int row = row0 + ai * 128 + m * 16;
                f32x4 c0 = {1.f, 1.f, 1.f, 1.f}, c1 = c0, s0 = {0.f, 0.f, 0.f, 0.f}, s1 = s0;
                if (lat) {
                    const int t = row & 2047, pos = axis ? (t & 63) : (t >> 6);
                    const float* cp = rope + pos * 16 + i0;
                    c0 = *(const f32x4*)cp; c1 = *(const f32x4*)(cp + 4); s0 = *(const f32x4*)(cp + 1024); s1 = *(const f32x4*)(cp + 1028);
                }
                bf16_t* rowp = O + (size_t)row * 3072 + colt + wc * 32 + 8 * fq;
#pragma unroll
                for (int bj = 0; bj < 2; ++bj) {
                    f32x4 v0 = acc[ai][bj][m][0], v1 = acc[ai][bj][m][1];
                    if (lat) {
                        f32x4 p0, p1;
#pragma unroll
                        for (int j = 0; j < 4; ++j) { p0[j] = __shfl_xor(v0[j], 32); p1[j] = __shfl_xor(v1[j], 32); }
                        if (second) { v0 = v0 * c0 + p0 * s0; v1 = v1 * c1 + p1 * s1; }
                        else        { v0 = v0 * c0 - p0 * s0; v1 = v1 * c1 - p1 * s1; }
                    }
                    v0 = v0 * sc; v1 = v1 * sc;
                    u32x4 w; w.x = pg8::cvt_pk_bf16(v0[0], v0[1]); w.y = pg8::cvt_pk_bf16(v0[2], v0[3]); w.z = pg8::cvt_pk_bf16(v1[0], v1[1]); w.w = pg8::cvt_pk_bf16(v1[2], v1[3]);
                    *(u32x4*)(rowp + bj * 128) = w;
                }
            }
    }
};
struct EpiT {
    static constexpr bool PERM = true, AFTER_DRAIN = false;
    bf16_t* VT; bf16_t* FTL; bf16_t* FTC; int mode;
    __device__ __forceinline__ void operator()(const f32x4 (&acc)[2][2][4][2], const Unit& u, int wr, int wc, int fr, int fq) const {
        const int row0 = u.pm * 256 + wr * 64 + fr;
        const int col0 = u.pn * 256 + wc * 32 + 8 * fq;
#pragma unroll
        for (int ai = 0; ai < 2; ++ai)
#pragma unroll
            for (int m = 0; m < 4; ++m) {
                const int row = row0 + ai * 128 + m * 16;
#pragma unroll
                for (int bj = 0; bj < 2; ++bj) {
                    const int col = col0 + bj * 128;
                    const f32x4 v0 = acc[ai][bj][m][0], v1 = acc[ai][bj][m][1];
                    u32x4 w; w.x = pg8::cvt_pk_bf16(v0[0], v0[1]); w.y = pg8::cvt_pk_bf16(v0[2], v0[3]); w.z = pg8::cvt_pk_bf16(v1[0], v1[1]); w.w = pg8::cvt_pk_bf16(v1[2], v1[3]);
                    bf16_t* dst;
                    if (mode == 1 || row < 1536) dst = VT + (size_t)row * MTOT + col;
                    else {
                        const int rr = row - 1536, part = rr >> 9, j = rr & 511;
                        if (col < MLAT) { const int b = col >> 11, t = col & 2047; dst = FTL + ((size_t)(b * 512 + j) * 4096 + part * 2048 + t); }
                        else { const int cc = col - MLAT, b = cc >> 8, t = cc & 255; dst = FTC + ((size_t)(b * 512 + j) * 512 + part * 256 + t); }
                    }
                    *(u32x4*)dst = w;
                }
            }
    }
};
struct EpiFour {
    static constexpr bool PERM = true, AFTER_DRAIN = false;
    bf16_t* CAT; int rowbase, L; float scale;
    __device__ __forceinline__ void operator()(const f32x4 (&acc)[2][2][4][2], const Unit& u, int wr, int wc, int fr, int fq) const {
        const int row0 = u.pm * 256 + wr * 64 + fr;
        const int b = u.pn >> 1;
        const int j0 = (u.pn & 1) * 256 + wc * 32 + 8 * fq;
#pragma unroll
        for (int ai = 0; ai < 2; ++ai)
#pragma unroll
            for (int m = 0; m < 4; ++m) {
                const int k = row0 + ai * 128 + m * 16;
                bf16_t* rowp = CAT + (size_t)(rowbase + b * L + k) * 2048 + 1536 + j0;
#pragma unroll
                for (int bj = 0; bj < 2; ++bj) {
                    const f32x4 v0 = acc[ai][bj][m][0] * scale, v1 = acc[ai][bj][m][1] * scale;
                    u32x4 w; w.x = pg8::cvt_pk_bf16(v0[0], v0[1]); w.y = pg8::cvt_pk_bf16(v0[2], v0[3]); w.z = pg8::cvt_pk_bf16(v1[0], v1[1]); w.w = pg8::cvt_pk_bf16(v1[2], v1[3]);
                    *(u32x4*)(rowp + bj * 128) = w;
                }
            }
    }
};
struct EpiResid {
    static constexpr bool PERM = true, AFTER_DRAIN = false;
    bf16_t* MB; const float* gate;
    __device__ __forceinline__ void operator()(const f32x4 (&acc)[2][2][4][2], const Unit& u, int wr, int wc, int fr, int fq) const {
        const int row0 = u.pm * 256 + wr * 64 + fr, col0 = u.pn * 256 + wc * 32 + 8 * fq;
        const int r = u.pm < 64 ? (u.pm >> 3) : 8;
        const float* gp = gate + r * NMOD + col0;
        f32x4 g[2][2];
#pragma unroll
        for (int bj = 0; bj < 2; ++bj)
#pragma unroll
            for (int n = 0; n < 2; ++n) g[bj][n] = *(const f32x4*)(gp + bj * 128 + 4 * n);
#pragma unroll
        for (int ai = 0; ai < 2; ++ai)
#pragma unroll
            for (int m = 0; m < 4; ++m) {
                bf16_t* rowp = MB + (size_t)(row0 + ai * 128 + m * 16) * DM + col0;
#pragma unroll
                for (int bj = 0; bj < 2; ++bj) {
                    const f32x4 v0 = acc[ai][bj][m][0] * g[bj][0], v1 = acc[ai][bj][m][1] * g[bj][1];
                    u32x4 w; w.x = pg8::cvt_pk_bf16(v0[0], v0[1]); w.y = pg8::cvt_pk_bf16(v0[2], v0[3]); w.z = pg8::cvt_pk_bf16(v1[0], v1[1]); w.w = pg8::cvt_pk_bf16(v1[2], v1[3]);
                    *(u32x4*)(rowp + bj * 128) = w;
                }
            }
    }
};
struct EpiUp {
    static constexpr bool PERM = true, AFTER_DRAIN = false;
    bf16_t* A1; bf16_t* V1;
    __device__ __forceinline__ void operator()(const f32x4 (&acc)[2][2][4][2], const Unit& u, int wr, int wc, int fr, int fq) const {
        const int row0 = u.pm * 256 + wr * 64 + fr, col0 = u.pn * 128 + wc * 32 + 8 * fq;
#pragma unroll
        for (int ai = 0; ai < 2; ++ai)
#pragma unroll
            for (int m = 0; m < 4; ++m) {
                const size_t off = (size_t)(row0 + ai * 128 + m * 16) * DFF + col0;
#pragma unroll
                for (int bj = 0; bj < 2; ++bj) {
                    const f32x4 v0 = acc[ai][bj][m][0], v1 = acc[ai][bj][m][1];
                    u32x4 w; w.x = pg8::cvt_pk_bf16(v0[0], v0[1]); w.y = pg8::cvt_pk_bf16(v0[2], v0[3]); w.z = pg8::cvt_pk_bf16(v1[0], v1[1]); w.w = pg8::cvt_pk_bf16(v1[2], v1[3]);
                    *(u32x4*)((bj ? V1 : A1) + off) = w;
                }
            }
    }
};
__device__ __forceinline__ float dpp_ror1(float x) { return __builtin_bit_cast(float, __builtin_amdgcn_update_dpp(0, __builtin_bit_cast(int, x), 0x121, 0xf, 0xf, false)); }
__device__ __forceinline__ float dpp_rol1(float x) { return __builtin_bit_cast(float, __builtin_amdgcn_update_dpp(0, __builtin_bit_cast(int, x), 0x12F, 0xf, 0xf, false)); }
struct EpiUpFused {
    static constexpr bool PERM = true, AFTER_DRAIN = false;
    bf16_t* HID; float* EA; float* EP; float* EV; const float* cw; const float* cb; float* xch;
    __device__ __forceinline__ void operator()(const f32x4 (&acc)[2][2][4][2], const Unit& u, int wr, int wc, int fr, int fq) const {
        const int lc0 = wc * 32 + 8 * fq, col0 = u.pn * 128 + lc0;
        const int row0 = u.pm * 256 + wr * 64 + fr;
#pragma unroll
        for (int ai = 0; ai < 2; ++ai) {
            const int sg = ai * 2 + wr;
            if (fr == 0) { *(f32x4*)(xch + (sg * 2 + 0) * 128 + lc0) = acc[ai][0][0][0]; *(f32x4*)(xch + (sg * 2 + 0) * 128 + lc0 + 4) = acc[ai][0][0][1]; }
            if (fr == 15) { *(f32x4*)(xch + (sg * 2 + 1) * 128 + lc0) = acc[ai][0][3][0]; *(f32x4*)(xch + (sg * 2 + 1) * 128 + lc0 + 4) = acc[ai][0][3][1]; }
        }
        asm volatile("s_waitcnt lgkmcnt(0)" ::: "memory");
        __builtin_amdgcn_s_barrier();
        asm volatile("" ::: "memory");
        f32x4 w0[2], w1[2], w2[2], bb[2];
#pragma unroll
        for (int n = 0; n < 2; ++n) { w0[n] = *(const f32x4*)(cw + col0 + 4 * n); w1[n] = *(const f32x4*)(cw + DFF + col0 + 4 * n); w2[n] = *(const f32x4*)(cw + 2 * DFF + col0 + 4 * n); bb[n] = *(const f32x4*)(cb + col0 + 4 * n); }
#pragma unroll
        for (int ai = 0; ai < 2; ++ai) {
            const int sg = ai * 2 + wr;
            f32x4 extp[2], extn[2];
#pragma unroll
            for (int n = 0; n < 2; ++n) {
                extp[n] = sg > 0 ? *(const f32x4*)(xch + ((sg - 1) * 2 + 1) * 128 + lc0 + 4 * n) : (f32x4){0.f, 0.f, 0.f, 0.f};
                extn[n] = sg < 3 ? *(const f32x4*)(xch + ((sg + 1) * 2 + 0) * 128 + lc0 + 4 * n) : (f32x4){0.f, 0.f, 0.f, 0.f};
            }
            f32x4 hid[4][2], cvs[4][2];
#pragma unroll
            for (int n = 0; n < 2; ++n)
#pragma unroll
                for (int j = 0; j < 4; ++j) {
                    float a[4], r[4], l[4];
#pragma unroll
                    for (int m = 0; m < 4; ++m) { a[m] = acc[ai][0][m][n][j]; r[m] = dpp_ror1(a[m]); l[m] = dpp_rol1(a[m]); }
#pragma unroll
                    for (int m = 0; m < 4; ++m) {
                        const float pv = fr > 0 ? r[m] : (m > 0 ? r[m > 0 ? m - 1 : 0] : extp[n][j]);
                        const float nv = fr < 15 ? l[m] : (m < 3 ? l[m < 3 ? m + 1 : 3] : extn[n][j]);
                        const float cv = bb[n][j] + pv * w0[n][j] + a[m] * w1[n][j] + nv * w2[n][j];
                        cvs[m][n][j] = cv;
                        hid[m][n][j] = gelu_f(cv) * acc[ai][1][m][n][j];
                    }
                }
#pragma unroll
            for (int m = 0; m < 4; ++m) {
                u32x4 w; w.x = pg8::cvt_pk_bf16(hid[m][0][0], hid[m][0][1]); w.y = pg8::cvt_pk_bf16(hid[m][0][2], hid[m][0][3]); w.z = pg8::cvt_pk_bf16(hid[m][1][0], hid[m][1][1]); w.w = pg8::cvt_pk_bf16(hid[m][1][2], hid[m][1][3]);
                *(u32x4*)(HID + (size_t)(row0 + ai * 128 + m * 16) * DFF + col0) = w;
            }
            if (sg == 0 && fr == 0) {
                const size_t eo = (size_t)(u.pm * 2 + 0) * DFF + col0;
#pragma unroll
                for (int n = 0; n < 2; ++n) { *(f32x4*)(EA + eo + 4 * n) = acc[ai][0][0][n]; *(f32x4*)(EP + eo + 4 * n) = cvs[0][n]; *(f32x4*)(EV + eo + 4 * n) = acc[ai][1][0][n]; }
            }
            if (sg == 3 && fr == 15) {
                const size_t eo = (size_t)(u.pm * 2 + 1) * DFF + col0;
#pragma unroll
                for (int n = 0; n < 2; ++n) { *(f32x4*)(EA + eo + 4 * n) = acc[ai][0][3][n]; *(f32x4*)(EP + eo + 4 * n) = cvs[3][n]; *(f32x4*)(EV + eo + 4 * n) = acc[ai][1][3][n]; }
            }
        }
    }
};
struct EpiH1 {
    static constexpr bool PERM = true, AFTER_DRAIN = false;
    bf16_t* Q1; _Float16* LF; bf16_t* G1; const float* lbraw; int row_off, pn_off;
    __device__ __forceinline__ void operator()(const f32x4 (&acc)[2][2][4][2], const Unit& u, int wr, int wc, int fr, int fq) const {
        const int row0 = row_off + u.pm * 256 + wr * 64 + fr;
        const int pnn = u.pn + pn_off;
        const int seg = pnn >> 3;
        const int cs0 = (pnn & 7) * 256 + wc * 32 + 8 * fq;
        if (seg == 0 || seg == 3) {
            bf16_t* O = seg == 0 ? Q1 : G1;
#pragma unroll
            for (int ai = 0; ai < 2; ++ai)
#pragma unroll
                for (int m = 0; m < 4; ++m) {
                    bf16_t* rowp = O + (size_t)(row0 + ai * 128 + m * 16) * DM + cs0;
#pragma unroll
                    for (int bj = 0; bj < 2; ++bj) {
                        f32x4 v0 = acc[ai][bj][m][0], v1 = acc[ai][bj][m][1];
#pragma unroll
                        for (int j = 0; j < 4; ++j) { v0[j] = silu_f(v0[j]); v1[j] = silu_f(v1[j]); }
                        u32x4 w; w.x = pg8::cvt_pk_bf16(v0[0], v0[1]); w.y = pg8::cvt_pk_bf16(v0[2], v0[3]); w.z = pg8::cvt_pk_bf16(v1[0], v1[1]); w.w = pg8::cvt_pk_bf16(v1[2], v1[3]);
                        *(u32x4*)(rowp + bj * 128) = w;
                    }
                }
        } else {
            const int d = seg - 1;
            _Float16* O = LF + (size_t)d * MTOT * DM;
            float lb[2][8];
#pragma unroll
            for (int bj = 0; bj < 2; ++bj)
#pragma unroll
                for (int e = 0; e < 8; ++e) {
                    const int c = cs0 + bj * 128 + e;
                    lb[bj][e] = sigmoid_f(lbraw[(d * 2 + 1) * DM + c] - lbraw[(d * 2 + 0) * DM + c]);
                }
#pragma unroll
            for (int ai = 0; ai < 2; ++ai)
#pragma unroll
                for (int m = 0; m < 4; ++m) {
                    _Float16* rowp = O + (size_t)(row0 + ai * 128 + m * 16) * DM + cs0;
#pragma unroll
                    for (int bj = 0; bj < 2; ++bj) {
                        h16x8 w;
#pragma unroll
                        for (int e = 0; e < 8; ++e) {
                            const float x = (e < 4) ? acc[ai][bj][m][0][e & 3] : acc[ai][bj][m][1][e & 3];
                            const float f = lb[bj][e] + (1.0f - lb[bj][e]) * sigmoid_f(x);
                            w[e] = (_Float16)__logf(f);
                        }
                        *(h16x8*)(rowp + bj * 128) = w;
                    }
                }
        }
    }
};

#define LDS_WAIT() asm volatile("s_waitcnt lgkmcnt(0)" ::: "memory")
__device__ __forceinline__ void transpose_item(const float* W, int ldw, int k0, int n0, bf16_t* WT, int K, int drow0, float* scr, int lane) {
    f32x4 v[8];
    const int kr = lane >> 3, c4 = (lane & 7) * 4;
#pragma unroll
    for (int i = 0; i < 8; ++i) v[i] = *(const f32x4*)(W + (size_t)(k0 + kr + 8 * i) * ldw + n0 + c4);
#pragma unroll
    for (int i = 0; i < 8; ++i) { float* s = scr + (kr + 8 * i) * 33 + c4; s[0] = v[i][0]; s[1] = v[i][1]; s[2] = v[i][2]; s[3] = v[i][3]; }
    LDS_WAIT(); asm volatile("" ::: "memory");
    const int c = lane & 7;
#pragma unroll
    for (int j = 0; j < 4; ++j) { const int n = (lane >> 3) + 8 * j; const float* s = scr + (8 * c) * 33 + n;
        u32x4 o; o.x = pk2(s[0 * 33], s[1 * 33]); o.y = pk2(s[2 * 33], s[3 * 33]); o.z = pk2(s[4 * 33], s[5 * 33]); o.w = pk2(s[6 * 33], s[7 * 33]);
        *(u32x4*)(WT + (size_t)(drow0 + n) * K + k0 + 8 * c) = o; }
    LDS_WAIT(); asm volatile("" ::: "memory");
}
struct TJob { const float* W; int ldw, K, ncols, col0; bf16_t* WT; int mode; };
__device__ __forceinline__ int tjob_items(const TJob& j) { return (j.K / 64) * (j.ncols / 32); }
__device__ __forceinline__ void tjob_run(const TJob& j, int drow_base, int it, float* scr, int lane) {
    const int nblk = j.ncols / 32, kb = it / nblk, nb = it % nblk;
    const int n = nb * 32;
    int drow;
    if (j.mode == 0) drow = drow_base + n;
    else { const int bj = n / DFF, r = n % DFF, pn = r >> 7, i = r & 127; drow = 256 * pn + 128 * bj + i; }
    transpose_item(j.W, j.ldw, kb * 64, j.col0 + n, j.WT, j.K, drow, scr, lane);
}

__device__ __forceinline__ void row_op(const float* zrow, float* hrow, const float* g, const float* bt, bool ln1, const float* sh, const float* sc, bf16_t* urow, int lane, const bf16_t* mrow = nullptr, const f32x4* gpre = nullptr, const f32x4* bpre = nullptr) {
    f32x4 v[8];
    const f32x4* zr = (const f32x4*)zrow + lane;
#pragma unroll
    for (int j = 0; j < 8; ++j) v[j] = zr[64 * j];
    f32x4 scv[8], shv[8];
    if (urow) {
#pragma unroll
        for (int j = 0; j < 8; ++j) { scv[j] = *((const f32x4*)sc + lane + 64 * j); shv[j] = *((const f32x4*)sh + lane + 64 * j); }
    }
    if (mrow) {
#pragma unroll
        for (int j = 0; j < 8; ++j) {
            const u32x2 mw = *((const u32x2*)mrow + lane + 64 * j);
            v[j][0] = v[j][0] * ALPHA_F + bf2f((unsigned short)(mw.x & 0xffffu)); v[j][1] = v[j][1] * ALPHA_F + bf2f((unsigned short)(mw.x >> 16));
            v[j][2] = v[j][2] * ALPHA_F + bf2f((unsigned short)(mw.y & 0xffffu)); v[j][3] = v[j][3] * ALPHA_F + bf2f((unsigned short)(mw.y >> 16));
        }
    }
    if (ln1) {
        float s = 0.f;
#pragma unroll
        for (int j = 0; j < 8; ++j) s += (v[j][0] + v[j][1]) + (v[j][2] + v[j][3]);
        const float mean = wave_sum(s) * (1.f / DM); float s2 = 0.f;
#pragma unroll
        for (int j = 0; j < 8; ++j) { v[j] = v[j] - mean; s2 += (v[j][0] * v[j][0] + v[j][1] * v[j][1]) + (v[j][2] * v[j][2] + v[j][3] * v[j][3]); }
        const float rstd = 1.f / sqrtf(wave_sum(s2) * (1.f / DM) + LN_EPS_F);
#pragma unroll
        for (int j = 0; j < 8; ++j) { const f32x4 gg = gpre ? gpre[j] : *((const f32x4*)g + lane + 64 * j), bb = bpre ? bpre[j] : *((const f32x4*)bt + lane + 64 * j); v[j] = v[j] * rstd * gg + bb; }
        if (hrow) {
#pragma unroll
            for (int j = 0; j < 8; ++j) *((f32x4*)hrow + lane + 64 * j) = v[j];
        }
    }
    if (urow) {
        float s = 0.f;
#pragma unroll
        for (int j = 0; j < 8; ++j) s += (v[j][0] + v[j][1]) + (v[j][2] + v[j][3]);
        const float mean = wave_sum(s) * (1.f / DM); float s2 = 0.f;
#pragma unroll
        for (int j = 0; j < 8; ++j) { v[j] = v[j] - mean; s2 += (v[j][0] * v[j][0] + v[j][1] * v[j][1]) + (v[j][2] * v[j][2] + v[j][3] * v[j][3]); }
        const float rstd = 1.f / sqrtf(wave_sum(s2) * (1.f / DM) + LN_EPS_F);
#pragma unroll
        for (int j = 0; j < 8; ++j) {
            const f32x4 o = v[j] * rstd * (scv[j] + 1.0f) + shv[j];
            u32x2 w; w.x = pk2(o[0], o[1]); w.y = pk2(o[2], o[3]);
            *((u32x2*)urow + lane + 64 * j) = w;
        }
    }
}

__device__ __forceinline__ void attn_unit(unsigned char* lds, const bf16_t* QK, const bf16_t* VT0, bf16_t* CAT, const float* subln, float lam, int unit) {
    int tid_ = threadIdx.x; asm volatile("" : "+v"(tid_)); const int tid = tid_, lane = tid & 63, wave = tid >> 6, fr = lane & 15, fq = lane >> 4;
    const int qg = wave >> 1, sm = wave & 1;
    int b, h, qrow0, ntiles;
    int rot = 0;
    if (unit < 1536) { b = unit / 192; const int rem = unit % 192; h = rem >> 4; qrow0 = b * SEQ + (rem & 15) * 128; ntiles = 36; rot = ((rem & 15) * 9) >> 2; }
    else { const int uu = unit - 1536; b = uu / 24; const int rem = uu % 24; h = rem >> 1; qrow0 = MLAT + b * CTXL + (rem & 1) * 128; ntiles = 4; }
    bf16_t* Kt0 = (bf16_t*)lds;
    float* XO = (float*)lds;
    bf16x8 q[2][2];
#pragma unroll
    for (int qt = 0; qt < 2; ++qt)
#pragma unroll
        for (int kk = 0; kk < 2; ++kk)
            q[qt][kk] = *(const bf16x8*)(QK + (size_t)(qrow0 + qg * 32 + qt * 16 + fr) * 3072 + h * 128 + sm * 64 + kk * 32 + fq * 8);
    f32x4 O[2][8];
#pragma unroll
    for (int qt = 0; qt < 2; ++qt)
#pragma unroll
        for (int dt = 0; dt < 8; ++dt) O[qt][dt] = (f32x4){0.f, 0.f, 0.f, 0.f};
    float mrun[2] = {-INFINITY, -INFINITY}, lrun[2] = {0.f, 0.f};
    u32x4 kreg[2], vreg[2];
#define keyrow_(i) ((i) < 4 ? (MLAT + b * CTXL + 64 * (i)) : (b * SEQ + 64 * ((i) - 4)))
#define keyrow(i) keyrow_(((i) + rot) % ntiles)
#define AT_LOAD(i_) do { const int kr0 = keyrow(i_); _Pragma("unroll") for (int c = 0; c < 2; ++c) { const int id = tid + 512 * c; \
            kreg[c] = *(const u32x4*)(QK + (size_t)(kr0 + (id >> 4)) * 3072 + 1536 + h * 128 + (id & 15) * 8); \
            vreg[c] = *(const u32x4*)(VT0 + (size_t)(h * 128 + (id >> 3)) * MTOT + kr0 + (id & 7) * 8); } } while (0)
#define AT_STORE(buf_) do { bf16_t* Kb = Kt0 + (buf_) * 18432; bf16_t* Vb = Kb + 8704; _Pragma("unroll") for (int c = 0; c < 2; ++c) { const int id = tid + 512 * c; \
            *(u32x4*)(Kb + (id >> 4) * 136 + (id & 15) * 8) = kreg[c]; \
            *(u32x4*)(Vb + (id >> 3) * 72 + (id & 7) * 8) = vreg[c]; } } while (0)
    __syncthreads();
    AT_LOAD(0); AT_STORE(0);
    if (ntiles > 1) AT_LOAD(1);
    __syncthreads();
    const bool grpB = wave >= 4;
    bf16x8 pb[2][2];
#define AT_PV(Vt_) do { _Pragma("unroll") for (int hf = 0; hf < 2; ++hf) { bf16x8 av_[8]; \
        _Pragma("unroll") for (int d4 = 0; d4 < 4; ++d4) _Pragma("unroll") for (int kk = 0; kk < 2; ++kk) { const int dt = hf * 4 + d4; \
            const u32x2 lo = *(const u32x2*)((Vt_) + (dt * 16 + fr) * 72 + kk * 32 + 4 * fq); \
            const u32x2 hi = *(const u32x2*)((Vt_) + (dt * 16 + fr) * 72 + kk * 32 + 16 + 4 * fq); \
            u32x4 w; w.x = lo.x; w.y = lo.y; w.z = hi.x; w.w = hi.y; av_[d4 * 2 + kk] = __builtin_bit_cast(bf16x8, w); } \
        __builtin_amdgcn_sched_barrier(0); \
        _Pragma("unroll") for (int d4 = 0; d4 < 4; ++d4) _Pragma("unroll") for (int kk = 0; kk < 2; ++kk) \
            _Pragma("unroll") for (int qt = 0; qt < 2; ++qt) O[qt][hf * 4 + d4] = __builtin_amdgcn_mfma_f32_16x16x32_bf16(av_[d4 * 2 + kk], pb[qt][kk], O[qt][hf * 4 + d4], 0, 0, 0); \
        __builtin_amdgcn_sched_barrier(0); } } while (0)
    int rb = 0;
    for (int i = 0; i <= ntiles; ++i) {
        const int rbn = rb == 2 ? 0 : rb + 1, rbp = rb == 0 ? 2 : rb - 1;
        const bf16_t* Kt = Kt0 + rb * 18432;
        if (i + 1 < ntiles) AT_STORE(rbn);
        if (i + 2 < ntiles) AT_LOAD(i + 2);
        if (grpB && i > 0) AT_PV(Kt0 + rbp * 18432 + 8704);
        if (i < ntiles) {
        f32x4 s[4][2];
#pragma unroll
        for (int kt = 0; kt < 4; ++kt) {
            const bf16x8 a0 = *(const bf16x8*)(Kt + (kt * 16 + fr) * 136 + sm * 64 + fq * 8);
            const bf16x8 a1 = *(const bf16x8*)(Kt + (kt * 16 + fr) * 136 + sm * 64 + 32 + fq * 8);
#pragma unroll
            for (int qt = 0; qt < 2; ++qt) {
                f32x4 z = {0.f, 0.f, 0.f, 0.f};
                z = __builtin_amdgcn_mfma_f32_16x16x32_bf16(a0, q[qt][0], z, 0, 0, 0);
                s[kt][qt] = __builtin_amdgcn_mfma_f32_16x16x32_bf16(a1, q[qt][1], z, 0, 0, 0);
            }
        }
#pragma unroll
        for (int qt = 0; qt < 2; ++qt) {
            float mx = -INFINITY;
#pragma unroll
            for (int kt = 0; kt < 4; ++kt)
#pragma unroll
                for (int j = 0; j < 4; ++j) mx = fmaxf(mx, s[kt][qt][j]);
            if (__builtin_amdgcn_ballot_w64(mx > mrun[qt] + 40.0f) != 0ull) {
                mx = fmaxf(mx, __shfl_xor(mx, 16)); mx = fmaxf(mx, __shfl_xor(mx, 32));
                const float mnew = fmaxf(mrun[qt], mx);
                const float alpha = __builtin_amdgcn_exp2f(mrun[qt] - mnew);
                mrun[qt] = mnew;
                lrun[qt] = lrun[qt] * alpha;
#pragma unroll
                for (int dt = 0; dt < 8; ++dt) O[qt][dt] = O[qt][dt] * alpha;
            }
            const float mnew = mrun[qt];
            float ls = 0.f;
#pragma unroll
            for (int kt = 0; kt < 4; ++kt)
#pragma unroll
                for (int j = 0; j < 4; ++j) { const float p = __builtin_amdgcn_exp2f(s[kt][qt][j] - mnew); s[kt][qt][j] = p; ls += p; }
            lrun[qt] += ls;
#pragma unroll
            for (int kk = 0; kk < 2; ++kk) {
                u32x4 w; w.x = pg8::cvt_pk_bf16(s[2 * kk][qt][0], s[2 * kk][qt][1]); w.y = pg8::cvt_pk_bf16(s[2 * kk][qt][2], s[2 * kk][qt][3]);
                w.z = pg8::cvt_pk_bf16(s[2 * kk + 1][qt][0], s[2 * kk + 1][qt][1]); w.w = pg8::cvt_pk_bf16(s[2 * kk + 1][qt][2], s[2 * kk + 1][qt][3]);
                pb[qt][kk] = __builtin_bit_cast(bf16x8, w);
            }
        }
        if (!grpB) AT_PV(Kt + 8704);
        }
        rb = rbn;
        __syncthreads();
    }
#undef AT_PV
#undef AT_LOAD
#undef AT_STORE
    float inv[2];
#pragma unroll
    for (int qt = 0; qt < 2; ++qt) { float l = lrun[qt]; l += __shfl_xor(l, 16); l += __shfl_xor(l, 32); inv[qt] = 1.0f / l; }
    __syncthreads();
    if (sm == 1) {
#pragma unroll
        for (int qt = 0; qt < 2; ++qt)
#pragma unroll
            for (int dt = 0; dt < 8; ++dt)
#pragma unroll
                for (int j = 0; j < 4; ++j) XO[(qg * 64 + (qt * 8 + dt) * 4 + j) * 64 + lane] = O[qt][dt][j] * inv[qt];
    }
    __syncthreads();
    if (sm == 0) {
#pragma unroll
        for (int qt = 0; qt < 2; ++qt) {
            float ss = 0.f;
#pragma unroll
            for (int dt = 0; dt < 8; ++dt)
#pragma unroll
                for (int j = 0; j < 4; ++j) { const float o = O[qt][dt][j] * inv[qt] - lam * XO[(qg * 64 + (qt * 8 + dt) * 4 + j) * 64 + lane]; O[qt][dt][j] = o; ss += o * o; }
            ss += __shfl_xor(ss, 16); ss += __shfl_xor(ss, 32);
            const float r = (1.0f - LAM_INIT0) / sqrtf(ss * (1.0f / 128.0f) + RMS_EPS_F);
            bf16_t* rowp = CAT + (size_t)(qrow0 + qg * 32 + qt * 16 + fr) * 2048 + h * 128 + 4 * fq;
#pragma unroll
            for (int dt = 0; dt < 8; ++dt) {
                const f32x4 w4 = *(const f32x4*)(subln + dt * 16 + 4 * fq);
                u32x2 w; w.x = pk2(O[qt][dt][0] * r * w4[0], O[qt][dt][1] * r * w4[1]); w.y = pk2(O[qt][dt][2] * r * w4[2], O[qt][dt][3] * r * w4[3]);
                *(u32x2*)(rowp + dt * 16) = w;
            }
        }
    }
}

constexpr int SC_RAWQ = 0, SC_RAWLF = 16384, SC_RAWVT = 32768, SC_PREP = 63488, SC_PREP_SZ = 36864;
constexpr int SP_QI = 0, SP_QR = 8704, SP_KR = 17408, SP_KET = 26112, SP_DEC = 36352;
#define chunk_row0(ci) ((ci) < 8 ? (MLAT + b * CTXL + 32 * (dir ? 7 - (ci) : (ci))) : (b * SEQ + 32 * (dir ? 63 - ((ci) - 8) : ((ci) - 8))))
template <int G_, int DIR_>
__device__ __forceinline__ void scan_elem_t(unsigned char* lds, int ci, int k) {
    const int cur = ci & 1; const bool need_out = ci >= 8;
    const bf16_t* rawq = (const bf16_t*)(lds + SC_RAWQ + cur * 8192) + k;
    const _Float16* rawlf = (const _Float16*)(lds + SC_RAWLF + cur * 8192) + k;
    unsigned char* pb = lds + SC_PREP + cur * SC_PREP_SZ;
    bf16_t* QI = (bf16_t*)(pb + SP_QI) + k; bf16_t* QR = (bf16_t*)(pb + SP_QR) + k; bf16_t* KR = (bf16_t*)(pb + SP_KR) + k; bf16_t* KET = (bf16_t*)(pb + SP_KET); float* DEC = (float*)(pb + SP_DEC);
    float run = 0.f, ref = 0.f, cums[8], lfv[8];
#pragma unroll
    for (int p = 0; p < 32; ++p) {
        const int i = DIR_ ? 31 - p : p;
        const float x = (float)rawlf[i * 128];
        run += x;
        if ((p >> 3) == G_) { cums[p & 7] = run; lfv[p & 7] = x; }
        if (p == 15) ref = run;
    }
    const float tot = run;
    const float E1 = __expf(fminf(-ref, 80.f)), E2 = __expf(fminf(ref - tot, 80.f));
    float ket[8], ec[8];
#pragma unroll
    for (int e = 0; e < 8; ++e) { ket[e] = (1.0f - __expf(lfv[e])) * __expf(tot - cums[e]); ec[e] = __expf(cums[e]); }
    if (need_out) {
#pragma unroll
        for (int e = 0; e < 8; e += 2) {
            const int p0 = 8 * G_ + e, i0 = DIR_ ? 31 - p0 : p0, i1 = DIR_ ? i0 - 1 : i0 + 1;
            const float qa = bf2f(rawq[i0 * 128]) * ec[e], qb = bf2f(rawq[i1 * 128]) * ec[e + 1];
            const unsigned wi = pg8::cvt_pk_bf16(qa, qb), wr_ = pg8::cvt_pk_bf16(qa * E1, qb * E1), wk = pg8::cvt_pk_bf16(ket[e] * E2, ket[e + 1] * E2);
            QI[i0 * 136] = (bf16_t)(wi & 0xffffu); QI[i1 * 136] = (bf16_t)(wi >> 16);
            QR[i0 * 136] = (bf16_t)(wr_ & 0xffffu); QR[i1 * 136] = (bf16_t)(wr_ >> 16);
            KR[i0 * 136] = (bf16_t)(wk & 0xffffu); KR[i1 * 136] = (bf16_t)(wk >> 16);
        }
    }
    u32x4 wv;
    if (DIR_) { wv.x = pg8::cvt_pk_bf16(ket[7], ket[6]); wv.y = pg8::cvt_pk_bf16(ket[5], ket[4]); wv.z = pg8::cvt_pk_bf16(ket[3], ket[2]); wv.w = pg8::cvt_pk_bf16(ket[1], ket[0]); }
    else      { wv.x = pg8::cvt_pk_bf16(ket[0], ket[1]); wv.y = pg8::cvt_pk_bf16(ket[2], ket[3]); wv.z = pg8::cvt_pk_bf16(ket[4], ket[5]); wv.w = pg8::cvt_pk_bf16(ket[6], ket[7]); }
    const int i0 = DIR_ ? 24 - 8 * G_ : 8 * G_;
    *(u32x4*)(KET + k * 40 + i0) = wv;
    if (G_ == 0) DEC[k] = __expf(tot);
}
__device__ __forceinline__ void scan_elem(unsigned char* lds, int ci, int dir, int k, int g) {
    const int sel = __builtin_amdgcn_readfirstlane(g * 2 + dir);
    switch (sel) {
        case 0: scan_elem_t<0, 0>(lds, ci, k); break;
        case 1: scan_elem_t<0, 1>(lds, ci, k); break;
        case 2: scan_elem_t<1, 0>(lds, ci, k); break;
        case 3: scan_elem_t<1, 1>(lds, ci, k); break;
        case 4: scan_elem_t<2, 0>(lds, ci, k); break;
        case 5: scan_elem_t<2, 1>(lds, ci, k); break;
        case 6: scan_elem_t<3, 0>(lds, ci, k); break;
        default: scan_elem_t<3, 1>(lds, ci, k); break;
    }
}
__device__ __forceinline__ void scan_mfma(unsigned char* lds, f32x4 (&S)[8], int ci, int vt3, int dir, int r0, bf16_t* Od, int h, int w, int fr, int fq) {
    const int cur = ci & 1; const bool need_out = ci >= 8;
    const bf16_t* rawvt = (const bf16_t*)(lds + SC_RAWVT + vt3 * 10240);
    unsigned char* pb = lds + SC_PREP + cur * SC_PREP_SZ;
    const bf16_t* QI = (const bf16_t*)(pb + SP_QI); const bf16_t* QR = (const bf16_t*)(pb + SP_QR); const bf16_t* KR = (const bf16_t*)(pb + SP_KR); const bf16_t* KET = (const bf16_t*)(pb + SP_KET); const float* DEC = (const float*)(pb + SP_DEC);
    if (need_out) {
        f32x4 sc[2][2];
#pragma unroll
        for (int st = 0; st < 2; ++st)
#pragma unroll
            for (int tt = 0; tt < 2; ++tt) {
                f32x4 z = {0.f, 0.f, 0.f, 0.f};
#pragma unroll
                for (int kk = 0; kk < 4; ++kk) {
                    const bf16x8 a = *(const bf16x8*)(KR + (st * 16 + fr) * 136 + kk * 32 + fq * 8);
                    const bf16x8 bq = *(const bf16x8*)(QR + (tt * 16 + fr) * 136 + kk * 32 + fq * 8);
                    z = __builtin_amdgcn_mfma_f32_16x16x32_bf16(a, bq, z, 0, 0, 0);
                }
#pragma unroll
                for (int j = 0; j < 4; ++j) { const int s_ = st * 16 + 4 * fq + j, t_ = tt * 16 + fr; const bool ok = dir ? (s_ >= t_) : (s_ <= t_); z[j] = ok ? z[j] : 0.f; }
                sc[st][tt] = z;
            }
        bf16x8 Sb[4];
#pragma unroll
        for (int kk = 0; kk < 4; ++kk) {
            u32x4 wv; wv.x = pg8::cvt_pk_bf16(S[2 * kk][0], S[2 * kk][1]); wv.y = pg8::cvt_pk_bf16(S[2 * kk][2], S[2 * kk][3]);
            wv.z = pg8::cvt_pk_bf16(S[2 * kk + 1][0], S[2 * kk + 1][1]); wv.w = pg8::cvt_pk_bf16(S[2 * kk + 1][2], S[2 * kk + 1][3]);
            Sb[kk] = __builtin_bit_cast(bf16x8, wv);
        }
        const u32x2 vlo = *(const u32x2*)(rawvt + (16 * w + fr) * 40 + 4 * fq);
        const u32x2 vhi = *(const u32x2*)(rawvt + (16 * w + fr) * 40 + 16 + 4 * fq);
        u32x4 vw; vw.x = vlo.x; vw.y = vlo.y; vw.z = vhi.x; vw.w = vhi.y;
        const bf16x8 bv = __builtin_bit_cast(bf16x8, vw);
#pragma unroll
        for (int tt = 0; tt < 2; ++tt) {
            u32x4 pw; pw.x = pg8::cvt_pk_bf16(sc[0][tt][0], sc[0][tt][1]); pw.y = pg8::cvt_pk_bf16(sc[0][tt][2], sc[0][tt][3]);
            pw.z = pg8::cvt_pk_bf16(sc[1][tt][0], sc[1][tt][1]); pw.w = pg8::cvt_pk_bf16(sc[1][tt][2], sc[1][tt][3]);
            f32x4 o = {0.f, 0.f, 0.f, 0.f}, o2 = {0.f, 0.f, 0.f, 0.f};
            o = __builtin_amdgcn_mfma_f32_16x16x32_bf16(__builtin_bit_cast(bf16x8, pw), bv, o, 0, 0, 0);
#pragma unroll
            for (int kk = 0; kk < 4; ++kk) {
                const u32x2 alo = *(const u32x2*)(QI + (tt * 16 + fr) * 136 + kk * 32 + 4 * fq);
                const u32x2 ahi = *(const u32x2*)(QI + (tt * 16 + fr) * 136 + kk * 32 + 16 + 4 * fq);
                u32x4 aw; aw.x = alo.x; aw.y = alo.y; aw.z = ahi.x; aw.w = ahi.y;
                if (kk & 1) o2 = __builtin_amdgcn_mfma_f32_16x16x32_bf16(__builtin_bit_cast(bf16x8, aw), Sb[kk], o2, 0, 0, 0);
                else        o  = __builtin_amdgcn_mfma_f32_16x16x32_bf16(__builtin_bit_cast(bf16x8, aw), Sb[kk], o, 0, 0, 0);
            }
            o = o + o2;
#pragma unroll
            for (int j = 0; j < 4; ++j) Od[(size_t)(r0 + tt * 16 + 4 * fq + j) * DM + h * 128 + 16 * w + fr] = (bf16_t)f2bf(o[j]);
        }
    }
    const bf16x8 bvt = *(const bf16x8*)(rawvt + (16 * w + fr) * 40 + fq * 8);
#pragma unroll
    for (int i = 0; i < 8; ++i) {
        const f32x4 dec = *(const f32x4*)(DEC + 16 * i + 4 * fq);
        const bf16x8 a = *(const bf16x8*)(KET + (16 * i + fr) * 40 + fq * 8);
        S[i] = __builtin_amdgcn_mfma_f32_16x16x32_bf16(a, bvt, S[i] * dec, 0, 0, 0);
    }
}
__device__ __forceinline__ void scan_chain(unsigned char* lds, const bf16_t* Q1, const _Float16* LFd, const bf16_t* VT1, bf16_t* Od, int b, int h, int dir) {
    int tid_ = threadIdx.x; asm volatile("" : "+v"(tid_)); const int tid = tid_, lane = tid & 63, w = tid >> 6, fr = lane & 15, fq = lane >> 4;
    const int k = tid & 127, g = tid >> 7;
    f32x4 S[8];
#pragma unroll
    for (int i = 0; i < 8; ++i) S[i] = (f32x4){0.f, 0.f, 0.f, 0.f};
    u32x4 rq, rl, rv;
#define SC_LOAD(ci_) do { const int r_ = chunk_row0(ci_); \
        rq = *(const u32x4*)(Q1 + (size_t)(r_ + (tid >> 4)) * DM + h * 128 + (tid & 15) * 8); \
        rl = *(const u32x4*)(LFd + (size_t)(r_ + (tid >> 4)) * DM + h * 128 + (tid & 15) * 8); \
        rv = *(const u32x4*)(VT1 + (size_t)(h * 128 + (tid >> 2)) * MTOT + r_ + (tid & 3) * 8); } while (0)
#define SC_STORE(par_, v3_) do { \
        *(u32x4*)(lds + SC_RAWQ + (par_) * 8192 + (tid >> 4) * 256 + (tid & 15) * 16) = rq; \
        *(u32x4*)(lds + SC_RAWLF + (par_) * 8192 + (tid >> 4) * 256 + (tid & 15) * 16) = rl; \
        *(u32x4*)(lds + SC_RAWVT + (v3_) * 10240 + (tid >> 2) * 80 + (tid & 3) * 16) = rv; } while (0)
    SC_LOAD(0); SC_STORE(0, 0);
    SC_LOAD(1); SC_STORE(1, 1);
    __syncthreads();
    scan_elem(lds, 0, dir, k, g);
    __syncthreads();
    int v3 = 0;
    for (int ci = 0; ci < 72; ++ci) {
        const int r0 = chunk_row0(ci);
        if (ci + 2 < 72) SC_LOAD(ci + 2);
        scan_mfma(lds, S, ci, v3, dir, r0, Od, h, w, fr, fq);
        if (ci + 1 < 72) scan_elem(lds, ci + 1, dir, k, g);
        const int v3n = v3 == 0 ? 2 : v3 - 1;
        if (ci + 2 < 72) SC_STORE(ci & 1, v3n);
        v3 = v3 == 2 ? 0 : v3 + 1;
        __syncthreads();
    }
#undef SC_LOAD
#undef SC_STORE
}

#define LAS __attribute__((address_space(3)))
#define XB_TMO      128
#define XB_XCNT(j)  (256  + 64 * (j))
#define XB_XSUB(j)  (1280 + 64 * (j))
#define XB_XGEN(j)  (2304 + 64 * (j))
#define XB_TOP      3328
#define XB_TOPGEN   3392
#define XCD_BAR_WORDS 3456
#define XB_SPIN_CAP (1u << 18)

__device__ __forceinline__ unsigned xb_ld(unsigned* p)              { return __hip_atomic_load(p, __ATOMIC_RELAXED, __HIP_MEMORY_SCOPE_AGENT); }
__device__ __forceinline__ unsigned xb_add(unsigned* p, unsigned v) { return __hip_atomic_fetch_add(p, v, __ATOMIC_RELAXED, __HIP_MEMORY_SCOPE_AGENT); }
__device__ __forceinline__ unsigned xb_xcc_id() { return (unsigned)__builtin_amdgcn_s_getreg((3 << 11) | 20) & 0xFu; }
#define XB_SPIN(cond, bar) do { unsigned _sp = 0; while (cond) { __builtin_amdgcn_s_sleep(1); \
    if ((++_sp & 255u) == 0u) { if (xb_ld(&(bar)[XB_TMO])) break; if (_sp > XB_SPIN_CAP) { atomicAdd(&(bar)[XB_TMO], 1u); break; } } } } while (0)

struct XcdBarrier {
    unsigned* bar; unsigned x;
    volatile LAS unsigned* st;
};

__device__ __forceinline__ XcdBarrier xcd_barrier_post(unsigned* bar, volatile LAS unsigned* st) {
    XcdBarrier b; b.bar = bar; b.x = xb_xcc_id(); b.st = st;
    if (threadIdx.x == 0) (void)xb_add(&bar[XB_XCNT(b.x)], 1u);
    return b;
}
__device__ __forceinline__ void xcd_barrier_complete(unsigned* bar, unsigned x, unsigned& nloc, unsigned& nx) {
    const unsigned G = gridDim.x * gridDim.y * gridDim.z;
    unsigned sum, cnt, mine, sp = 0u;
    for (;;) {
        sum = 0u; cnt = 0u; mine = 0u;
#pragma unroll
        for (unsigned j = 0; j < 16; ++j) { const unsigned c = xb_ld(&bar[XB_XCNT(j)]); sum += c; cnt += (c > 0u) ? 1u : 0u; mine = (j == x) ? c : mine; }
        if (sum == G) break;
        __builtin_amdgcn_s_sleep(1);
        if ((++sp & 255u) == 0u) { if (xb_ld(&bar[XB_TMO])) break; if (sp > XB_SPIN_CAP) { atomicAdd(&bar[XB_TMO], 1u); break; } }
    }
    nloc = mine > 0u ? mine : 1u; nx = cnt > 0u ? cnt : 1u;
}

__device__ __forceinline__ void xcd_barrier(const XcdBarrier& b) {
    asm volatile("s_waitcnt vmcnt(0)" ::: "memory");
    __syncthreads();
    if (threadIdx.x == 0) {
        unsigned* bar = b.bar;
        __builtin_amdgcn_s_waitcnt(0);
        unsigned nloc = b.st[0], nx = b.st[1];
        if (nloc == 0u) { xcd_barrier_complete(bar, b.x, nloc, nx); b.st[0] = nloc; b.st[1] = nx; }
        const unsigned old = xb_add(&bar[XB_XSUB(b.x)], 1u);
        const unsigned gen = old / nloc;
        if (old + 1u == (gen + 1u) * nloc) {
            __builtin_amdgcn_fence(__ATOMIC_RELEASE, "agent");
            asm volatile("s_waitcnt vmcnt(0)" ::: "memory");
            const unsigned og = xb_add(&bar[XB_TOP], 1u);
            const unsigned tg = og / nx;
            if (og + 1u == (tg + 1u) * nx) xb_add(&bar[XB_TOPGEN], 1u);
            else XB_SPIN(xb_ld(&bar[XB_TOPGEN]) == tg, bar);
            __builtin_amdgcn_fence(__ATOMIC_ACQUIRE, "agent");
            xb_add(&bar[XB_XGEN(b.x)], 1u);
            asm volatile("s_waitcnt vmcnt(0)" ::: "memory");
        } else {
            XB_SPIN(xb_ld(&bar[XB_XGEN(b.x)]) == gen, bar);
            __builtin_amdgcn_fence(__ATOMIC_ACQUIRE, "agent");
            asm volatile("s_waitcnt vmcnt(0)" ::: "memory");
        }
    }
    __syncthreads();
}

__global__ void __launch_bounds__(512, 2) hybrid_fwd(Args args) {
    extern __shared__ __attribute__((aligned(16))) unsigned char lds[];
    cg::grid_group grid = cg::this_grid();
    const int tid = threadIdx.x, lane = tid & 63, wave = __builtin_amdgcn_readfirstlane(tid >> 6);
    const int G = gridDim.x, bid = blockIdx.x;
    const int gw = bid * 8 + wave, NGW = G * 8;
    unsigned char* ws = args.ws;
    PG8_LAS unsigned char* ldsg = (PG8_LAS unsigned char*)lds;

    const float* x = args.in[0]; const float* cvec = args.in[1]; const float* ctx = args.in[2]; const float* c_ctx = args.in[3];
    const float* mod_w = args.in[4]; const float* mod_b = args.in[5];
    const float* ln_mix_g = args.in[6]; const float* ln_mix_b = args.in[7]; const float* ln_ffn_g = args.in[8]; const float* ln_ffn_b = args.in[9];
    const float* even_w_in = args.in[10]; const float* even_w_out = args.in[11]; const float* diff_lambda = args.in[12]; const float* diff_subln = args.in[13];
    const float* hgrn_w_in = args.in[14]; const float* hgrn_w_out = args.in[15]; const float* hgrn_lb = args.in[16]; const float* hgrn_norm = args.in[17];
    const float* ffn_w_up = args.in[18]; const float* ffn_conv_w = args.in[19]; const float* ffn_conv_b = args.in[20]; const float* ffn_w_down = args.in[21];
    float* hlat = args.out;
    float* hctx = (float*)(ws + WS_HCTX);
    float* modv = (float*)(ws + WS_MODV);
    float* rope = (float*)(ws + WS_ROPE);
    bf16_t* U = (bf16_t*)(ws + WS_U);
    unsigned* ctl = (unsigned*)(ws + WS_CTL);
    if (tid < 64) ((volatile LAS unsigned*)((LAS unsigned char*)lds + LDS_MISC))[tid] = 0u;
    __syncthreads();
    const XcdBarrier xbar = xcd_barrier_post(ctl + 1024, (volatile LAS unsigned*)((LAS unsigned char*)lds + LDS_MISC + 32));
#define GRID_BAR() xcd_barrier(xbar)

    for (int rep = 0; rep < (PROBE == 3 ? 2 : 1); ++rep) {
        if (bid == 0) {
            for (int e = tid; e < 1024; e += 512) {
                const int pos = e >> 4, i = e & 15;
                const float inv = 1.0f / powf(10000.0f, (float)(2 * i) / 32.0f);
                const float ang = (float)pos * inv;
                rope[e] = cosf(ang); rope[1024 + e] = sinf(ang);
            }
        }
        {
            float* sl = (float*)lds;
            float* red = (float*)(lds + 81920);
            for (int e = tid; e < 9 * DM; e += 512) { const int r = e >> 11, kk = e & 2047; const float v = r < 8 ? cvec[r * DM + kk] : c_ctx[kk]; sl[e] = silu_f(v); }
            __syncthreads();
            const int cg4 = tid & 7, kg = tid >> 3;
            float* red2 = (float*)(lds + 81920);
            for (int it = bid; it < 768; it += G) {
                const int l = it / 384, n0 = (it % 384) * 32;
                const float* wp = mod_w + (size_t)l * DM * NMOD + (size_t)(kg * 32) * NMOD + n0 + cg4 * 4;
                f32x4 a[9];
#pragma unroll
                for (int r = 0; r < 9; ++r) a[r] = (f32x4){0.f, 0.f, 0.f, 0.f};
#pragma unroll 8
                for (int kk = 0; kk < 32; ++kk) {
                    const f32x4 wv = *(const f32x4*)(wp + (size_t)kk * NMOD);
#pragma unroll
                    for (int r = 0; r < 9; ++r) a[r] += wv * sl[r * DM + kg * 32 + kk];
                }
#pragma unroll
                for (int r = 0; r < 9; ++r)
#pragma unroll
                    for (int j = 0; j < 4; ++j) { float t = a[r][j]; t += __shfl_xor(t, 8); t += __shfl_xor(t, 16); t += __shfl_xor(t, 32); a[r][j] = t; }
                if (lane < 8) {
#pragma unroll
                    for (int r = 0; r < 9; ++r) *(f32x4*)(red2 + (wave * 9 + r) * 32 + lane * 4) = a[r];
                }
                __syncthreads();
                if (tid < 288) {
                    const int r = tid >> 5, c2 = tid & 31; float s = 0.f;
#pragma unroll
                    for (int q2 = 0; q2 < 8; ++q2) s += red2[(q2 * 9 + r) * 32 + c2];
                    modv[(size_t)(l * 9 + r) * NMOD + n0 + c2] = s + mod_b[l * NMOD + n0 + c2];
                }
                __syncthreads();
            }
        }
        {
            bf16_t* D2 = (bf16_t*)(ws + WS_D2);
            for (size_t e = (size_t)bid * 512 + tid; e < (size_t)2048 * 512; e += (size_t)G * 512) {
                const int kq = (int)(e >> 9), n0 = (int)(e & 511) * 8;
                float v[8];
#pragma unroll
                for (int j = 0; j < 8; ++j) { const int n = n0 + j; const int mm = (kq * (n & 2047)) & 2047; const float a = (float)mm * (1.0f / 1024.0f); v[j] = n < 2048 ? cospif(a) : -sinpif(a); }
                u32x4 w; w.x = pk2(v[0], v[1]); w.y = pk2(v[2], v[3]); w.z = pk2(v[4], v[5]); w.w = pk2(v[6], v[7]);
                *(u32x4*)(D2 + (size_t)kq * 4096 + n0) = w;
            }
            bf16_t* D2C = (bf16_t*)(ws + WS_D2C);
            for (int e = bid * 512 + tid; e < 256 * 64; e += G * 512) {
                const int kq = e >> 6, n0 = (e & 63) * 8;
                float v[8];
#pragma unroll
                for (int j = 0; j < 8; ++j) { const int n = n0 + j; const int mm = (kq * (n & 255)) & 255; const float a = (float)mm * (1.0f / 128.0f); v[j] = n < 256 ? cospif(a) : -sinpif(a); }
                u32x4 w; w.x = pk2(v[0], v[1]); w.y = pk2(v[2], v[3]); w.z = pk2(v[4], v[5]); w.w = pk2(v[6], v[7]);
                *(u32x4*)(D2C + (size_t)kq * 512 + n0) = w;
            }
        }
        __syncthreads();
        {
            float* wt = (float*)lds;
            float* tab = (float*)(lds + 64 * 129 * 4);
            bf16_t* W0VF = (bf16_t*)(ws + WS_W0VF);
            for (int it = bid; it < 128; it += G) {
                const int kb = it >> 2, gq = it & 3;
                __syncthreads();
                if (tid < 128) tab[tid] = cospif((float)tid * (1.0f / 64.0f));
                for (int e = tid; e < 64 * 128; e += 512) { const int kk = e >> 7, c = e & 127; wt[kk * 129 + c] = even_w_in[(size_t)(kb * 64 + kk) * 5120 + 4608 + gq * 128 + c]; }
                __syncthreads();
                const int kk = tid & 63, mg = tid >> 6;
                for (int mi = 0; mi < 16; ++mi) {
                    const int mm = mg * 16 + mi;
                    float sa = 0.f, sb = 0.f;
#pragma unroll 8
                    for (int c = 0; c < 128; ++c) { const float wv = wt[kk * 129 + c]; const int ph = (c * mm) & 127; sa += wv * tab[ph]; sb += wv * tab[(ph + 96) & 127]; }
                    W0VF[(size_t)(1536 + gq * 128 + mm) * DM + kb * 64 + kk] = (bf16_t)f2bf(sa);
                    W0VF[(size_t)(2048 + gq * 128 + mm) * DM + kb * 64 + kk] = (bf16_t)f2bf(sb);
                }
            }
        }
        __syncthreads();
        {
            float* scr = (float*)(lds + wave * 16384);
            int base = 0;
#define RUNJOB(W_, ldw_, K_, ncols_, col0_, WT_, mode_, drow_) do { const TJob jb{W_, ldw_, K_, ncols_, col0_, WT_, mode_}; const int ni = tjob_items(jb); \
                const int first = ((gw - base) % NGW + NGW) % NGW; for (int it = first; it < ni; it += NGW) tjob_run(jb, drow_, it, scr, lane); base += ni; } while (0)
            RUNJOB(even_w_in, 5120, DM, 3072, 0, (bf16_t*)(ws + WS_W0QK), 0, 0);
            RUNJOB(even_w_in, 5120, DM, 1536, 3072, (bf16_t*)(ws + WS_W0VF), 0, 0);
            RUNJOB(even_w_out, DM, DM, DM, 0, (bf16_t*)(ws + WS_W0OUT), 0, 0);
            RUNJOB(hgrn_w_in, 10240, DM, 6144, 0, (bf16_t*)(ws + WS_W1A), 0, 0);
            RUNJOB(hgrn_w_in, 10240, DM, DM, 6144, (bf16_t*)(ws + WS_W1V), 0, 0);
            RUNJOB(hgrn_w_in, 10240, DM, DM, 8192, (bf16_t*)(ws + WS_W1A), 0, 6144);
            RUNJOB(hgrn_w_out, DM, DM, DM, 0, (bf16_t*)(ws + WS_W1OUT), 0, 0);
            RUNJOB(ffn_w_up, 2 * DFF, DM, 2 * DFF, 0, (bf16_t*)(ws + WS_WUP), 1, 0);
            RUNJOB(ffn_w_up + (size_t)DM * 2 * DFF, 2 * DFF, DM, 2 * DFF, 0, (bf16_t*)(ws + WS_WUP + 43 * MiB), 1, 0);
            RUNJOB(ffn_w_down, DM, DFF, DM, 0, (bf16_t*)(ws + WS_WDN), 0, 0);
            RUNJOB(ffn_w_down + (size_t)DFF * DM, DM, DFF, DM, 0, (bf16_t*)(ws + WS_WDN + 21 * MiB + 512 * 1024), 0, 0);
#undef RUNJOB
        }
    }
    grid.sync();

    for (int r = gw; r < MTOT; r += NGW) {
        const bool lat = r < MLAT;
        const float* zr = lat ? x + (size_t)r * DM : ctx + (size_t)(r - MLAT) * DM;
        const float* mrow = modv + (size_t)(0 * 9 + (lat ? (r >> 11) : 8)) * NMOD;
        row_op(zr, nullptr, nullptr, nullptr, false, mrow + 0 * DM, mrow + 1 * DM, U + (size_t)r * DM, lane);
    }
    GRID_BAR();

    {
        pg8::Gemm g1{U, (const bf16_t*)(ws + WS_W0QK), MTOT, 3072, DM}; pg8::StaticOrder S1; S1.init(MTOT, 3072, G, bid);
        EpiQK E1{(bf16_t*)(ws + R_QK), rope};
        pg8::gemm_phase<EpiQK, pg8::StaticOrder, GEMM_ALIGN, GEMM_SP2>(ldsg, g1, S1, E1);
        pg8::Gemm g2{(const bf16_t*)(ws + WS_W0VF), U, 2560, MTOT, DM}; pg8::StaticOrder S2; S2.init(2560, MTOT, G, (bid + 128) % G);
        EpiT E2{(bf16_t*)(ws + R_VT0), (bf16_t*)(ws + R_FTL), (bf16_t*)(ws + R_FTC), 0};
        pg8::gemm_phase<EpiT, pg8::StaticOrder, GEMM_ALIGN, GEMM_SP2>(ldsg, g2, S2, E2);
    }
    GRID_BAR();

    {
        pg8::Gemm gf{(const bf16_t*)(ws + WS_D2), (const bf16_t*)(ws + R_FTL), 2048, 4096, 4096}; pg8::StaticOrder Sf; Sf.init(2048, 4096, G, bid);
        EpiFour Ef{(bf16_t*)(ws + R_CAT), 0, SEQ, 1.0f / 512.0f};
        pg8::gemm_phase<EpiFour, pg8::StaticOrder, GEMM_ALIGN, GEMM_SP2>(ldsg, gf, Sf, Ef);
        pg8::Gemm gc{(const bf16_t*)(ws + WS_D2C), (const bf16_t*)(ws + R_FTC), 256, 4096, 512}; pg8::StaticOrder Sc; Sc.init(256, 4096, G, (bid + G - 128) % G);
        EpiFour Ec{(bf16_t*)(ws + R_CAT), MLAT, CTXL, 0.005524271728019903f};
        pg8::gemm_phase<EpiFour, pg8::StaticOrder, GEMM_ALIGN, GEMM_SP2>(ldsg, gc, Sc, Ec);
        float lam;
        {
            const float d01 = wave_sum(diff_lambda[lane] * diff_lambda[64 + lane]);
            const float d23 = wave_sum(diff_lambda[128 + lane] * diff_lambda[192 + lane]);
            lam = expf(d01) - expf(d23) + LAM_INIT0;
        }
        volatile int* qslot = (volatile int*)(lds + LDS_MISC);
        const int xq0 = (int)(xbar.x & 7u);
        for (int dq = 0; dq < 8; ++dq) {
        const int xq = (xq0 + dq) & 7;
        for (;;) {
            __syncthreads();
            if (tid == 0) *qslot = (int)atomicAdd(ctl + 64 + 64 * xq, 1u);
            __syncthreads();
            const int idx = *qslot;
            if (idx >= 216) break;
            int unit;
            if (idx < 192) unit = (xq * 12 + (idx >> 4)) * 16 + (idx & 15);
            else unit = 1536 + (xq * 12 + ((idx - 192) >> 1)) * 2 + ((idx - 192) & 1);
            attn_unit(lds, (const bf16_t*)(ws + R_QK), (const bf16_t*)(ws + R_VT0), (bf16_t*)(ws + R_CAT), diff_subln, lam, unit);
        }
        }
    }
    GRID_BAR();

    {
        pg8::Gemm g{(const bf16_t*)(ws + R_CAT), (const bf16_t*)(ws + WS_W0OUT), MTOT, DM, DM}; pg8::StaticOrder S; S.init(MTOT, DM, G, bid);
        EpiResid E{(bf16_t*)(ws + R_MB), modv + 0 * 9 * NMOD + 2 * DM};
        pg8::gemm_phase<EpiResid, pg8::StaticOrder, GEMM_ALIGN, GEMM_SP2>(ldsg, g, S, E);
    }
    GRID_BAR();

#define HROW(r) ((r) < MLAT ? hlat + (size_t)(r) * DM : hctx + (size_t)((r) - MLAT) * DM)
    { f32x4 gpre[8], bpre[8];
#pragma unroll
    for (int j = 0; j < 8; ++j) { gpre[j] = *((const f32x4*)ln_mix_g + lane + 64 * j); bpre[j] = *((const f32x4*)ln_mix_b + lane + 64 * j); }
    for (int r = gw; r < MTOT; r += NGW) {
        const float* mrow = modv + (size_t)(0 * 9 + (r < MLAT ? (r >> 11) : 8)) * NMOD;
        row_op(r < MLAT ? x + (size_t)r * DM : ctx + (size_t)(r - MLAT) * DM, HROW(r), ln_mix_g, ln_mix_b, true, mrow + 3 * DM, mrow + 4 * DM, U + (size_t)r * DM, lane, (const bf16_t*)(ws + R_MB) + (size_t)r * DM, gpre, bpre);
    }
    }
    GRID_BAR();

#define FFN_PHASES(L, MROWS) \
    { \
        pg8::Gemm g{U, (const bf16_t*)(ws + WS_WUP + (size_t)(L) * 43 * MiB), (MROWS), 2 * DFF, DM}; pg8::StaticOrder S; S.init((MROWS), 2 * DFF, G, bid); \
        EpiUpFused E{(bf16_t*)(ws + R_A1), (float*)(ws + R_EDGE), (float*)(ws + R_EDGE + 4 * MiB), (float*)(ws + R_EDGE + 8 * MiB), ffn_conv_w + (size_t)(L) * 3 * DFF, ffn_conv_b + (size_t)(L) * DFF, (float*)(lds + LDS_MISC + 1024)}; \
        pg8::gemm_phase<EpiUpFused, pg8::StaticOrder, true, GEMM_SP2>(ldsg, g, S, E); \
    } \
    GRID_BAR(); \
    { \
        bf16_t* HID = (bf16_t*)(ws + R_A1); const float* EA = (const float*)(ws + R_EDGE); const float* EP = (const float*)(ws + R_EDGE + 4 * MiB); const float* EV = (const float*)(ws + R_EDGE + 8 * MiB); \
        const float* cw = ffn_conv_w + (size_t)(L) * 3 * DFF; \
        const int nedge = ((MROWS) / 256) * 2 * DFF; \
        for (int it = bid * 512 + tid; it < nedge; it += G * 512) { \
            const int c = it % DFF, pe = it / DFF, pm = pe >> 1, e = pe & 1; \
            const bool lat = pm < 64; \
            float nb = 0.f; \
            if (e == 0) { if (lat && (pm & 7) != 0) nb = EA[(size_t)((pm - 1) * 2 + 1) * DFF + c]; } \
            else { if (lat && (pm & 7) != 7) nb = EA[(size_t)((pm + 1) * 2 + 0) * DFF + c]; } \
            const float cv = EP[(size_t)pe * DFF + c] + nb * cw[(e ? 2 * DFF : 0) + c]; \
            HID[(size_t)(pm * 256 + (e ? 255 : 0)) * DFF + c] = (bf16_t)f2bf(gelu_f(cv) * EV[(size_t)pe * DFF + c]); \
        } \
    } \
    GRID_BAR(); \
    { \
        pg8::Gemm g{(const bf16_t*)(ws + R_A1), (const bf16_t*)(ws + WS_WDN + (size_t)(L) * (21 * MiB + 512 * 1024)), (MROWS), DM, DFF}; pg8::StaticOrder S; S.init((MROWS), DM, G, bid); \
        EpiResid E{(bf16_t*)(ws + R_MB), modv + (size_t)(L) * 9 * NMOD + 5 * DM}; \
        pg8::gemm_phase<EpiResid, pg8::StaticOrder, GEMM_ALIGN, GEMM_SP2>(ldsg, g, S, E); \
    } \
    GRID_BAR();

    FFN_PHASES(0, MTOT)

    { f32x4 gpre[8], bpre[8];
#pragma unroll
    for (int j = 0; j < 8; ++j) { gpre[j] = *((const f32x4*)ln_ffn_g + lane + 64 * j); bpre[j] = *((const f32x4*)ln_ffn_b + lane + 64 * j); }
    for (int r = gw; r < MTOT; r += NGW) {
        const float* mrow = modv + (size_t)(1 * 9 + (r < MLAT ? (r >> 11) : 8)) * NMOD;
        row_op(HROW(r), HROW(r), ln_ffn_g, ln_ffn_b, true, mrow + 0 * DM, mrow + 1 * DM, U + (size_t)r * DM, lane, (const bf16_t*)(ws + R_MB) + (size_t)r * DM, gpre, bpre);
    }
    }
    GRID_BAR();

    {
        pg8::Gemm g1{U, (const bf16_t*)(ws + WS_W1A), MLAT, 8192, DM}; pg8::StaticOrder S1; S1.init(MLAT, 8192, G, bid);
        EpiH1 E1{(bf16_t*)(ws + R_Q1), (_Float16*)(ws + R_LF), (bf16_t*)(ws + R_G1), hgrn_lb, 0, 0};
        pg8::gemm_phase<EpiH1, pg8::StaticOrder, GEMM_ALIGN, GEMM_SP2>(ldsg, g1, S1, E1);
        pg8::Gemm g1c{U + (size_t)MLAT * DM, (const bf16_t*)(ws + WS_W1A) + (size_t)2048 * DM, MCTX, 4096, DM}; pg8::StaticOrder S1c; S1c.init(MCTX, 4096, G, bid);
        EpiH1 E1c{(bf16_t*)(ws + R_Q1), (_Float16*)(ws + R_LF), (bf16_t*)(ws + R_G1), hgrn_lb, MLAT, 8};
        pg8::gemm_phase<EpiH1, pg8::StaticOrder, GEMM_ALIGN, GEMM_SP2>(ldsg, g1c, S1c, E1c);
        pg8::Gemm g2{(const bf16_t*)(ws + WS_W1V), U, 2048, MTOT, DM}; pg8::StaticOrder S2; S2.init(2048, MTOT, G, (bid + 128) % G);
        EpiT E2{(bf16_t*)(ws + R_VT1), nullptr, nullptr, 1};
        pg8::gemm_phase<EpiT, pg8::StaticOrder, GEMM_ALIGN, GEMM_SP2>(ldsg, g2, S2, E2);
    }
    GRID_BAR();

    for (int rep = 0; rep < (PROBE == 2 ? 2 : 1); ++rep)
    for (int chain = bid; chain < 256; chain += G) {
        const int dir = chain & 1, bh = chain >> 1, b = bh >> 4, h = bh & 15;
        __syncthreads();
        scan_chain(lds, (const bf16_t*)(ws + R_Q1), (const _Float16*)(ws + R_LF) + (size_t)dir * MTOT * DM, (const bf16_t*)(ws + R_VT1),
                   dir ? (bf16_t*)(ws + R_OB) : U, b, h, dir);
    }
    GRID_BAR();

    {
        const bf16_t* OF = U; const bf16_t* OB = (const bf16_t*)(ws + R_OB); const bf16_t* G1 = (const bf16_t*)(ws + R_G1); bf16_t* Y = (bf16_t*)(ws + R_Q1);
        float nw[32];
#pragma unroll
        for (int q8 = 0; q8 < 8; ++q8) { const f32x4 t4 = *(const f32x4*)(hgrn_norm + (lane & 3) * 32 + q8 * 4); nw[q8 * 4 + 0] = t4[0]; nw[q8 * 4 + 1] = t4[1]; nw[q8 * 4 + 2] = t4[2]; nw[q8 * 4 + 3] = t4[3]; }
        for (int r = gw; r < MLAT; r += NGW) {
            const size_t off = (size_t)r * DM + lane * 32;
            float o[32]; float ss = 0.f;
#pragma unroll
            for (int q4 = 0; q4 < 4; ++q4) {
                const u32x4 a = *(const u32x4*)(OF + off + q4 * 8), bq = *(const u32x4*)(OB + off + q4 * 8);
#pragma unroll
                for (int e = 0; e < 4; ++e) {
                    const float lo = bf2f((unsigned short)(a[e] & 0xffffu)) + bf2f((unsigned short)(bq[e] & 0xffffu));
                    const float hi = bf2f((unsigned short)(a[e] >> 16)) + bf2f((unsigned short)(bq[e] >> 16));
                    o[q4 * 8 + 2 * e] = lo; o[q4 * 8 + 2 * e + 1] = hi; ss += lo * lo + hi * hi;
                }
            }
            ss += __shfl_xor(ss, 1); ss += __shfl_xor(ss, 2);
            const float rs = 1.0f / sqrtf(ss * (1.0f / 128.0f) + RMS_EPS_F);
            const int d0 = (lane & 3) * 32;
#pragma unroll
            for (int q4 = 0; q4 < 4; ++q4) {
                const u32x4 gg = *(const u32x4*)(G1 + off + q4 * 8);
                u32x4 ow;
#pragma unroll
                for (int e = 0; e < 4; ++e) {
                    const float lo = o[q4 * 8 + 2 * e] * rs * nw[q4 * 8 + 2 * e] * bf2f((unsigned short)(gg[e] & 0xffffu));
                    const float hi = o[q4 * 8 + 2 * e + 1] * rs * nw[q4 * 8 + 2 * e + 1] * bf2f((unsigned short)(gg[e] >> 16));
                    ow[e] = pk2(lo, hi);
                }
                *(u32x4*)(Y + off + q4 * 8) = ow;
            }
        }
    }
    GRID_BAR();

    {
        pg8::Gemm g{(const bf16_t*)(ws + R_Q1), (const bf16_t*)(ws + WS_W1OUT), MLAT, DM, DM}; pg8::StaticOrder S; S.init(MLAT, DM, G, bid);
        EpiResid E{(bf16_t*)(ws + R_MB), modv + (size_t)1 * 9 * NMOD + 2 * DM};
        pg8::gemm_phase<EpiResid, pg8::StaticOrder, GEMM_ALIGN, GEMM_SP2>(ldsg, g, S, E);
    }
    GRID_BAR();

    { f32x4 gpre[8], bpre[8];
#pragma unroll
    for (int j = 0; j < 8; ++j) { gpre[j] = *((const f32x4*)(ln_mix_g + DM) + lane + 64 * j); bpre[j] = *((const f32x4*)(ln_mix_b + DM) + lane + 64 * j); }
    for (int r = gw; r < MLAT; r += NGW) {
        const float* mrow = modv + (size_t)(1 * 9 + (r >> 11)) * NMOD;
        row_op(HROW(r), HROW(r), ln_mix_g + DM, ln_mix_b + DM, true, mrow + 3 * DM, mrow + 4 * DM, U + (size_t)r * DM, lane, (const bf16_t*)(ws + R_MB) + (size_t)r * DM, gpre, bpre);
    }
    }
    GRID_BAR();

    FFN_PHASES(1, MLAT)

    f32x4 gpre[8], bpre[8];
#pragma unroll
    for (int j = 0; j < 8; ++j) { gpre[j] = *((const f32x4*)(ln_ffn_g + DM) + lane + 64 * j); bpre[j] = *((const f32x4*)(ln_ffn_b + DM) + lane + 64 * j); }
    for (int r = gw; r < MLAT; r += NGW)
        row_op(HROW(r), HROW(r), ln_ffn_g + DM, ln_ffn_b + DM, true, nullptr, nullptr, nullptr, lane, (const bf16_t*)(ws + R_MB) + (size_t)r * DM, gpre, bpre);
}

extern "C" void kernel_launch(void* const* d_in, const int* in_sizes, int n_in, void* d_out, int out_size, void* d_ws, size_t ws_size, hipStream_t stream) {
    static int grid = 0;
    if (grid == 0) {
        if (n_in != 22 || ws_size < WS_END) { fprintf(stderr, "kernel_launch: unexpected n_in %d / ws_size %zu\n", n_in, ws_size); grid = -1; return; }
        int dev = 0, cus = 0, per_cu = 0;
        (void)hipGetDevice(&dev);
        (void)hipDeviceGetAttribute(&cus, hipDeviceAttributeMultiprocessorCount, dev);
        if (hipFuncSetAttribute((const void*)hybrid_fwd, hipFuncAttributeMaxDynamicSharedMemorySize, LDS_BYTES) != hipSuccess) { fprintf(stderr, "kernel_launch: hipFuncSetAttribute failed\n"); grid = -1; return; }
        if (hipOccupancyMaxActiveBlocksPerMultiprocessor(&per_cu, (const void*)hybrid_fwd, 512, LDS_BYTES) != hipSuccess || per_cu < 1) { fprintf(stderr, "kernel_launch: occupancy query gives %d\n", per_cu); per_cu = 1; }
        (void)hipGetLastError();
        grid = cus * 1;
    }
    if (grid < 0) return;
    (void)hipMemsetAsync((char*)d_ws + WS_CTL, 0, 65536, stream);
    Args a{};
    for (int i = 0; i < 22; ++i) a.in[i] = (const float*)d_in[i];
    a.out = (float*)d_out; a.ws = (unsigned char*)d_ws; a.dbg = 0; a.pad = 0;
    void* kargs[] = {&a};
    hipError_t e = hipLaunchCooperativeKernel((const void*)hybrid_fwd, dim3(grid), dim3(512), kargs, LDS_BYTES, stream);
    if (e != hipSuccess) fprintf(stderr, "kernel_launch: cooperative launch failed: %s (grid %d)\n", hipGetErrorString(e), grid);
}
```

```cpp
#include <hip/hip_runtime.h>
#include <hip/hip_cooperative_groups.h>
#include <cstdio>
#include <cstdint>
namespace cg = cooperative_groups;
namespace pg8 {
#define PG8_LAS __attribute__((address_space(3)))
typedef unsigned short bf16_t;
typedef short bf16x8 __attribute__((ext_vector_type(8)));
typedef float f32x4 __attribute__((ext_vector_type(4)));
typedef unsigned u32x4 __attribute__((ext_vector_type(4)));
constexpr int BM = 256, BK = 64, HALF = 128, HTB = HALF * BK * 2  , STAGE_BYTES = 8 * HTB, NXCD = 8, WGM = 8;

__host__ __device__ __forceinline__ int lds_byte(int r, int c) { const int st = (r >> 4) * 2 + (c >> 5), rr = r & 15, cc = c & 31, ob = rr * 64 + cc * 2; return st * 1024 + (ob ^ (((ob >> 9) & 1) << 5)); }
__host__ __device__ __forceinline__ void stage_rc(int b, int& R, int& C) { const int st = b / 1024, sb = b % 1024, swz = sb ^ (((sb >> 9) & 1) << 5); R = (st >> 1) * 16 + swz / 64; C = (st & 1) * 32 + (swz % 64) / 2; }
__host__ __device__ __forceinline__ int perm32(int rho) { const int n = rho >> 4, i = rho & 15; return 8 * (i >> 2) + 4 * n + (i & 3); }

struct Unit { int pm, pn; };
struct Gemm { const bf16_t* A; const bf16_t* Bt; int M, N, K; };

struct StaticOrder {
    int nM, nN, nwg, G, c;
    __host__ __device__ void init(int M, int N, int G_, int c_) { nM = M / BM; nN = N / BM; nwg = nM * nN; G = G_; c = c_; }
    __host__ __device__ bool next(int i, Unit& u) const {
        const long L = (long)i * G + c; if (L >= nwg) return false;
        int wgid = (int)L; { const int q = nwg / NXCD, r = nwg % NXCD, xcd = wgid % NXCD, off = wgid / NXCD; wgid = (xcd < r ? xcd * (q + 1) : r * (q + 1) + (xcd - r) * q) + off; }
        const int nig = WGM * nN, gid = wgid / nig, fm = gid * WGM, gsz = (nM - fm) < WGM ? (nM - fm) : WGM;
        u.pm = fm + ((wgid % nig) % gsz); u.pn = (wgid % nig) / gsz; return true;
    }
    __device__ __forceinline__ void a_ready(const Unit&) const {}
    __device__ __forceinline__ void done(const Unit&) const {}
};
__device__ __forceinline__ unsigned cvt_pk_bf16(float lo, float hi) { unsigned r; asm volatile("v_cvt_pk_bf16_f32 %0, %1, %2" : "=v"(r) : "v"(lo), "v"(hi)); return r; }
typedef float f32x2 __attribute__((ext_vector_type(2)));
__device__ __forceinline__ f32x2 gelu_pk(f32x2 v) {
    const f32x2 av = __builtin_elementwise_abs(v), d = av * 0.2316418882f + 1.0f;
    f32x2 t; t.x = __builtin_amdgcn_rcpf(d.x); t.y = __builtin_amdgcn_rcpf(d.y);
    f32x2 q = t * 0.5307027145f + (-0.7265760135f); q = q * t + 0.7107068705f; q = q * t + (-0.142248368f); q = q * t + 0.127414796f; q = q * t;
    const f32x2 s = (v * v) * (-0.72134752044f);
    f32x2 e; e.x = __builtin_amdgcn_exp2f(s.x); e.y = __builtin_amdgcn_exp2f(s.y);
    const f32x2 m = v * (q * e), r = v - m;
    f32x2 o; o.x = v.x < 0.f ? m.x : r.x; o.y = v.y < 0.f ? m.y : r.y; return o;
}
template <class Epi, class Sched, bool ALIGN_EPI = false, bool SP2 = false>
__device__ __forceinline__ void gemm_phase(PG8_LAS unsigned char* lds, const Gemm g, const Sched& S, const Epi& E) {
    int tid_ = threadIdx.x; asm volatile("" : "+v"(tid_)); const int tid = tid_, wid = __builtin_amdgcn_readfirstlane(tid >> 6), lane = tid & 63, wr = wid >> 2, wc = wid & 3, fr = lane & 15, fq = lane >> 4;
    const int K = g.K, nt = K / BK;
    unsigned voffA[2], voffB[2];
#pragma unroll
    for (int i = 0; i < 2; ++i) { int R, C; stage_rc(tid * 16 + i * 8192, R, C); const int Rb = Epi::PERM ? ((R & ~31) + perm32(R & 31)) : R;
        voffA[i] = (unsigned)(R * K + C) * 2u; voffB[i] = (unsigned)(Rb * K + C) * 2u; }
    const size_t kstep = (size_t)(BK * 2);
    const size_t hstep = (size_t)HALF * K * 2;
    const size_t tstep = 2 * hstep;
    const unsigned ldsw = (unsigned)wid * 1024u;
    const int aoff = lds_byte(wr * 64 + fr, fq * 8), boff = lds_byte(wc * 32 + fr, fq * 8);
#define PG8_SA(b, h) (((b) * 2 + (h)) * HTB)
#define PG8_SB(b, h) ((4 + (b) * 2 + (h)) * HTB)
#define PG8_STAGE(bufoff, gbase, voff) do { _Pragma("unroll") for (int _i = 0; _i < 2; ++_i) \
        __builtin_amdgcn_global_load_lds((const unsigned*)((const char*)(gbase) + (voff)[_i]), (PG8_LAS unsigned*)(lds + (bufoff) + ldsw + _i * 8192), 16, 0, 0); } while (0)
#define PG8_LDA(dst, b, h) do { _Pragma("unroll") for (int m = 0; m < 4; ++m) _Pragma("unroll") for (int k = 0; k < 2; ++k) dst[m][k] = *(const PG8_LAS bf16x8*)(lds + PG8_SA(b, h) + aoff + m * 2048 + k * 1024); } while (0)
#define PG8_LDB(dst, b, h) do { _Pragma("unroll") for (int n = 0; n < 2; ++n) _Pragma("unroll") for (int k = 0; k < 2; ++k) dst[n][k] = *(const PG8_LAS bf16x8*)(lds + PG8_SB(b, h) + boff + n * 2048 + k * 1024); } while (0)
#define PG8_MMA(ai, bj, At, Bt) do { __builtin_amdgcn_s_setprio(1); _Pragma("unroll") for (int m = 0; m < 4; ++m) _Pragma("unroll") for (int n = 0; n < 2; ++n) _Pragma("unroll") for (int k = 0; k < 2; ++k) \
        acc[ai][bj][m][n] = __builtin_amdgcn_mfma_f32_16x16x32_bf16(Bt[n][k], At[m][k], acc[ai][bj][m][n], 0, 0, 0); __builtin_amdgcn_s_setprio(0); } while (0)
#define PG8_WAIT_V(n) asm volatile("s_waitcnt vmcnt(" #n ")" ::: "memory")
#define PG8_WAIT_L(n) asm volatile("s_waitcnt lgkmcnt(" #n ")" ::: "memory")
#define PG8_BAR __builtin_amdgcn_s_barrier()
#define PG8_SCHED __builtin_amdgcn_sched_barrier(0)
    Unit cur, nxt; int ui = 0;
    if (!S.next(0, cur)) return;
    f32x4 acc[2][2][4][2];
#pragma unroll
    for (int a = 0; a < 2; ++a)
#pragma unroll
        for (int b = 0; b < 2; ++b)
#pragma unroll
            for (int m = 0; m < 4; ++m)
#pragma unroll
                for (int n = 0; n < 2; ++n) acc[a][b][m][n] = (f32x4){0.f, 0.f, 0.f, 0.f};
    bf16x8 At[4][2], B0[2][2], B1[2][2];
    const char* cA = (const char*)g.A + (size_t)cur.pm * tstep; const char* cB = (const char*)g.Bt + (size_t)cur.pn * tstep;
    S.a_ready(cur);
    if constexpr (SP2) {
        PG8_STAGE(PG8_SB(0, 0), cB, voffB); PG8_STAGE(PG8_SB(0, 1), cB + hstep, voffB); PG8_STAGE(PG8_SA(0, 0), cA, voffA); PG8_STAGE(PG8_SA(0, 1), cA + hstep, voffA);
        if (wr == 1) PG8_BAR;
        PG8_WAIT_V(2); PG8_BAR;
        PG8_STAGE(PG8_SB(1, 0), cB + kstep, voffB); PG8_STAGE(PG8_SA(1, 0), cA + kstep, voffA); PG8_STAGE(PG8_SB(1, 1), cB + hstep + kstep, voffB);
        PG8_WAIT_V(6); PG8_BAR;
    } else {
        PG8_STAGE(PG8_SB(0, 0), cB, voffB); PG8_STAGE(PG8_SA(0, 0), cA, voffA); PG8_STAGE(PG8_SB(0, 1), cB + hstep, voffB); PG8_STAGE(PG8_SA(0, 1), cA + hstep, voffA);
        if (wr == 1) PG8_BAR;
        PG8_WAIT_V(4); PG8_BAR;
        PG8_STAGE(PG8_SB(1, 0), cB + kstep, voffB); PG8_STAGE(PG8_SA(1, 0), cA + kstep, voffA); PG8_STAGE(PG8_SB(1, 1), cB + hstep + kstep, voffB);
        PG8_WAIT_V(6); PG8_BAR;
    }
    for (;;) {
        const bool has_next = S.next(ui + 1, nxt);
        const char* nA = has_next ? (const char*)g.A + (size_t)nxt.pm * tstep : cA; const char* nB = has_next ? (const char*)g.Bt + (size_t)nxt.pn * tstep : cB;
        for (int t = 0; t < nt; t += 2) {
            const bool last = (t == nt - 2);
            const char* a1 = cA + (size_t)(t + 1) * kstep;
            const char* a2 = last ? nA : cA + (size_t)(t + 2) * kstep; const char* b2 = last ? nB : cB + (size_t)(t + 2) * kstep;
            const char* a3 = a2 + kstep; const char* b3 = b2 + kstep;
            if (last && has_next) S.a_ready(nxt);
            if constexpr (SP2) {
            PG8_LDB(B0, 0, 0); PG8_LDB(B1, 0, 1); PG8_SCHED; PG8_LDA(At, 0, 0); PG8_STAGE(PG8_SA(1, 1), a1 + hstep, voffA);
            PG8_WAIT_V(8); PG8_WAIT_L(0); PG8_BAR; PG8_MMA(0, 0, At, B0); PG8_MMA(0, 1, At, B1); PG8_BAR; PG8_SCHED;
            PG8_LDA(At, 0, 1); PG8_STAGE(PG8_SB(0, 0), b2, voffB); PG8_STAGE(PG8_SB(0, 1), b2 + hstep, voffB); PG8_STAGE(PG8_SA(0, 0), a2, voffA);
            PG8_WAIT_V(8); PG8_WAIT_L(0); PG8_BAR; PG8_MMA(1, 0, At, B0); PG8_MMA(1, 1, At, B1); PG8_BAR; PG8_SCHED;
            PG8_LDB(B0, 1, 0); PG8_LDB(B1, 1, 1); PG8_SCHED; PG8_LDA(At, 1, 0); PG8_STAGE(PG8_SA(0, 1), a2 + hstep, voffA);
            PG8_WAIT_V(8); PG8_WAIT_L(0); PG8_BAR; PG8_MMA(0, 0, At, B0); PG8_MMA(0, 1, At, B1); PG8_BAR; PG8_SCHED;
            PG8_LDA(At, 1, 1); PG8_STAGE(PG8_SB(1, 0), b3, voffB); PG8_STAGE(PG8_SB(1, 1), b3 + hstep, voffB); PG8_STAGE(PG8_SA(1, 0), a3, voffA);
            PG8_WAIT_V(8); PG8_WAIT_L(0); PG8_BAR; PG8_MMA(1, 0, At, B0); PG8_MMA(1, 1, At, B1); PG8_BAR; PG8_SCHED;
            } else {
            PG8_LDB(B0, 0, 0); PG8_SCHED; PG8_LDA(At, 0, 0); PG8_STAGE(PG8_SA(1, 1), a1 + hstep, voffA);
            PG8_WAIT_L(8); PG8_BAR; PG8_WAIT_L(0); PG8_MMA(0, 0, At, B0); PG8_BAR; PG8_SCHED;
            PG8_LDB(B1, 0, 1); PG8_STAGE(PG8_SB(0, 0), b2, voffB);
            PG8_BAR; PG8_WAIT_L(0); PG8_MMA(0, 1, At, B1); PG8_BAR;
            PG8_LDA(At, 0, 1); PG8_STAGE(PG8_SA(0, 0), a2, voffA);
            PG8_BAR; PG8_WAIT_L(0); PG8_MMA(1, 0, At, B0); PG8_BAR; PG8_SCHED;
            PG8_STAGE(PG8_SB(0, 1), b2 + hstep, voffB);
            PG8_WAIT_V(6); PG8_BAR; PG8_MMA(1, 1, At, B1); PG8_BAR;
            PG8_LDB(B0, 1, 0); PG8_SCHED; PG8_LDA(At, 1, 0); PG8_STAGE(PG8_SA(0, 1), a2 + hstep, voffA);
            PG8_WAIT_L(8); PG8_BAR; PG8_WAIT_L(0); PG8_MMA(0, 0, At, B0); PG8_BAR; PG8_SCHED;
            PG8_LDB(B1, 1, 1); PG8_STAGE(PG8_SB(1, 0), b3, voffB);
            PG8_BAR; PG8_WAIT_L(0); PG8_MMA(0, 1, At, B1); PG8_BAR;
            PG8_LDA(At, 1, 1); PG8_STAGE(PG8_SA(1, 0), a3, voffA);
            PG8_BAR; PG8_WAIT_L(0); PG8_MMA(1, 0, At, B0); PG8_BAR; PG8_SCHED;
            PG8_STAGE(PG8_SB(1, 1), b3 + hstep, voffB);
            PG8_WAIT_V(6); PG8_BAR; PG8_MMA(1, 1, At, B1); PG8_BAR;
            }
        }
        if constexpr (ALIGN_EPI) { if (wr == 0) PG8_BAR; }
        if constexpr (!Epi::AFTER_DRAIN) { E(acc, cur, wr, wc, fr, fq); S.done(cur); }
        if (!has_next) break;
#pragma unroll
        for (int a = 0; a < 2; ++a)
#pragma unroll
            for (int b = 0; b < 2; ++b)
#pragma unroll
                for (int m = 0; m < 4; ++m)
#pragma unroll
                    for (int n = 0; n < 2; ++n) acc[a][b][m][n] = (f32x4){0.f, 0.f, 0.f, 0.f};
        cur = nxt; cA = nA; cB = nB; ++ui;
        if constexpr (ALIGN_EPI) { if (wr == 1) PG8_BAR; }
    }
    PG8_WAIT_V(0);
    if constexpr (!ALIGN_EPI) { if (wr == 0) PG8_BAR; }
    PG8_BAR;
    if constexpr (Epi::AFTER_DRAIN) { E.fused(acc, cur, wr, wc, fr, fq, lds, wid, lane); S.done(cur); }
#undef PG8_SA
#undef PG8_SB
#undef PG8_STAGE
#undef PG8_LDA
#undef PG8_LDB
#undef PG8_MMA
#undef PG8_WAIT_V
#undef PG8_WAIT_L
#undef PG8_BAR
#undef PG8_SCHED
}
}

using pg8::bf16_t; using pg8::bf16x8; using pg8::f32x4; using pg8::u32x4; using pg8::Unit;
typedef _Float16 h16x8 __attribute__((ext_vector_type(8)));
typedef unsigned u32x2 __attribute__((ext_vector_type(2)));
#ifndef PROBE
#define PROBE 0
#endif
constexpr bool GEMM_ALIGN = true, GEMM_SP2 = true;
constexpr int DM = 2048, NBATCH = 8, SEQ = 2048, CTXL = 256, MLAT = NBATCH * SEQ, MCTX = NBATCH * CTXL, MTOT = MLAT + MCTX;
constexpr int DFF = 5504, NMOD = 6 * DM;
constexpr float ALPHA_F = 1.4142135623730951f;
constexpr float LN_EPS_F = 1e-6f, RMS_EPS_F = 1e-5f;
constexpr float LAM_INIT0 = 0.2f;
constexpr float QSCALE = 0.125f * 1.4426950408889634f;

constexpr size_t MiB = 1u << 20;
constexpr size_t WS_CTL = 0;
constexpr size_t WS_MODV = 1 * MiB;
constexpr size_t WS_ROPE = 2 * MiB;
constexpr size_t WS_W0QK = 4 * MiB;
constexpr size_t WS_W0VF = 16 * MiB;
constexpr size_t WS_W0OUT = 26 * MiB;
constexpr size_t WS_W1A = 34 * MiB;
constexpr size_t WS_W1V = 66 * MiB;
constexpr size_t WS_W1OUT = 74 * MiB;
constexpr size_t WS_WUP = 82 * MiB;
constexpr size_t WS_WDN = 168 * MiB;
constexpr size_t WS_D2 = 211 * MiB;
constexpr size_t WS_D2C = 227 * MiB;
constexpr size_t WS_HCTX = 228 * MiB;
constexpr size_t WS_U = 244 * MiB;
constexpr size_t WS_R = 316 * MiB;
constexpr size_t WS_END = 768 * MiB;
constexpr size_t R_QK = WS_R;
constexpr size_t R_VT0 = WS_R + 108 * MiB;
constexpr size_t R_FTL = WS_R + 162 * MiB;
constexpr size_t R_FTC = WS_R + 194 * MiB;
constexpr size_t R_CAT = WS_R + 198 * MiB;
constexpr size_t R_A1 = WS_R;
constexpr size_t R_V1 = WS_R + 194 * MiB;
constexpr size_t R_MB = WS_R + 272 * MiB;
constexpr size_t R_EDGE = WS_R + 390 * MiB;
constexpr size_t R_Q1 = WS_R;
constexpr size_t R_LF = WS_R + 72 * MiB;
constexpr size_t R_G1 = WS_R + 216 * MiB;
constexpr size_t R_VT1 = WS_R + 288 * MiB;
constexpr size_t R_OB = WS_R + 360 * MiB;

constexpr int LDS_BYTES = 152576;
constexpr int LDS_MISC = 147456;

struct Args {
    const float* in[22]; float* out; unsigned char* ws; int dbg; int pad;
};

__device__ __forceinline__ float bf2f(unsigned short v) { return __builtin_bit_cast(float, (unsigned)v << 16); }
__device__ __forceinline__ unsigned f2bf(float f) { return pg8::cvt_pk_bf16(f, f) & 0xffffu; }
__device__ __forceinline__ unsigned pk2(float lo, float hi) { return pg8::cvt_pk_bf16(lo, hi); }
__device__ __forceinline__ float wave_sum(float v) {
#pragma unroll
    for (int o = 1; o < 64; o <<= 1) v += __shfl_xor(v, o);
    return v;
}
__device__ __forceinline__ float silu_f(float x) { return x * __builtin_amdgcn_rcpf(1.0f + __expf(-x)); }
__device__ __forceinline__ float sigmoid_f(float x) { return __builtin_amdgcn_rcpf(1.0f + __expf(-x)); }
__device__ __forceinline__ float gelu_f(float v) {
    const float av = fabsf(v), t = __builtin_amdgcn_rcpf(av * 0.2316418882f + 1.0f);
    float q = t * 0.5307027145f + (-0.7265760135f); q = q * t + 0.7107068705f; q = q * t + (-0.142248368f); q = q * t + 0.127414796f; q = q * t;
    const float e = __builtin_amdgcn_exp2f((v * v) * (-0.72134752044f));
    const float m = v * (q * e);
    return v < 0.f ? m : v - m;
}

struct EpiQK {
    static constexpr bool PERM = true, AFTER_DRAIN = false;
    bf16_t* O; const float* rope;
    __device__ __forceinline__ void operator()(const f32x4 (&acc)[2][2][4][2], const Unit& u, int wr, int wc, int fr, int fq) const {
        const int row0 = u.pm * 256 + wr * 64 + fr;
        const int colt = u.pn * 256;
        const bool isq = colt < 1536;
        const float sc = isq ? QSCALE : 1.0f;
        const bool lat = (u.pm < 64);
        const int axis = wc & 1;
        const bool second = fq >= 2;
        const int i0 = 8 * (fq & 1);
#pragma unroll
        for (int ai = 0; ai < 2; ++ai)
#pragma unroll
            for (int m = 0; m < 4; ++m) {
                const int row = row0 + ai * 128 + m * 16;
                f32x4 c0 = {1.f, 1.f, 1.f, 1.f}, c1 = c0, s0 = {0.f, 0.f, 0.f, 0.f}, s1 = s0;
                if (lat) {
                    const int t = row & 2047, pos = axis ? (t & 63) : (t >> 6);
                    const float* cp = rope + pos * 16 + i0;
                    c0 = *(const f32x4*)cp; c1 = *(const f32x4*)(cp + 4); s0 = *(const f32x4*)(cp + 1024); s1 = *(const f32x4*)(cp + 1028);
                }
                bf16_t* rowp = O + (size_t)row * 3072 + colt + wc * 32 + 8 * fq;
#pragma unroll
                for (int bj = 0; bj < 2; ++bj) {
                    f32x4 v0 = acc[ai][bj][m][0], v1 = acc[ai][bj][m][1];
                    if (lat) {
                        f32x4 p0, p1;
#pragma unroll
                        for (int j = 0; j < 4; ++j) { p0[j] = __shfl_xor(v0[j], 32); p1[j] = __shfl_xor(v1[j], 32); }
                        if (second) { v0 = v0 * c0 + p0 * s0; v1 = v1 * c1 + p1 * s1; }
                        else        { v0 = v0 * c0 - p0 * s0; v1 = v1 * c1 - p1 * s1; }
                    }
                    v0 = v0 * sc; v1 = v1 * sc;
                    u32x4 w; w.x = pg8::cvt_pk_bf16(v0[0], v0[1]); w.y = pg8::cvt_pk_bf16(v0[2], v0[3]); w.z = pg8::cvt_pk_bf16(v1[0], v1[1]); w.w = pg8::cvt_pk_bf16(v1[2], v1[3]);
                    *(u32x4*)(rowp + bj * 128) = w;
                }
            }
    }
};
struct EpiT {
    static constexpr bool PERM = true, AFTER_DRAIN = false;
    bf16_t* VT; bf16_t* FTL; bf16_t* FTC; int mode;
    __device__ __forceinline__ void operator()(const f32x4 (&acc)[2][2][4][2], const Unit& u, int wr, int wc, int fr, int fq) const {
        const int row0 = u.pm * 256 + wr * 64 + fr;
        const int col0 = u.pn * 256 + wc * 32 + 8 * fq;
#pragma unroll
        for (int ai = 0; ai < 2; ++ai)
#pragma unroll
            for (int m = 0; m < 4; ++m) {
                const int row = row0 + ai * 128 + m * 16;
#pragma unroll
                for (int bj = 0; bj < 2; ++bj) {
                    const int col = col0 + bj * 128;
                    const f32x4 v0 = acc[ai][bj][m][0], v1 = acc[ai][bj][m][1];
                    u32x4 w; w.x = pg8::cvt_pk_bf16(v0[0], v0[1]); w.y = pg8::cvt_pk_bf16(v0[2], v0[3]); w.z = pg8::cvt_pk_bf16(v1[0], v1[1]); w.w = pg8::cvt_pk_bf16(v1[2], v1[3]);
                    bf16_t* dst;
                    if (mode == 1 || row < 1536) dst = VT + (size_t)row * MTOT + col;
                    else {
                        const int rr = row - 1536, part = rr >> 9, j = rr & 511;
                        if (col < MLAT) { const int b = col >> 11, t = col & 2047; dst = FTL + ((size_t)(b * 512 + j) * 4096 + part * 2048 + t); }
                        else { const int cc = col - MLAT, b = cc >> 8, t = cc & 255; dst = FTC + ((size_t)(b * 512 + j) * 512 + part * 256 + t); }
                    }
                    *(u32x4*)dst = w;
                }
            }
    }
};
struct EpiFour {
    static constexpr bool PERM = true, AFTER_DRAIN = false;
    bf16_t* CAT; int rowbase, L; float scale;
    __device__ __forceinline__ void operator()(const f32x4 (&acc)[2][2][4][2], const Unit& u, int wr, int wc, int fr, int fq) const {
        const int row0 = u.pm * 256 + wr * 64 + fr;
        const int b = u.pn >> 1;
        const int j0 = (u.pn & 1) * 256 + wc * 32 + 8 * fq;
#pragma unroll
        for (int ai = 0; ai < 2; ++ai)
#pragma unroll
            for (int m = 0; m < 4; ++m) {
                const int k = row0 + ai * 128 + m * 16;
                bf16_t* rowp = CAT + (size_t)(rowbase + b * L + k) * 2048 + 1536 + j0;
#pragma unroll
                for (int bj = 0; bj < 2; ++bj) {
                    const f32x4 v0 = acc[ai][bj][m][0] * scale, v1 = acc[ai][bj][m][1] * scale;
                    u32x4 w; w.x = pg8::cvt_pk_bf16(v0[0], v0[1]); w.y = pg8::cvt_pk_bf16(v0[2], v0[3]); w.z = pg8::cvt_pk_bf16(v1[0], v1[1]); w.w = pg8::cvt_pk_bf16(v1[2], v1[3]);
                    *(u32x4*)(rowp + bj * 128) = w;
                }
            }
    }
};
struct EpiResid {
    static constexpr bool PERM = true, AFTER_DRAIN = false;
    bf16_t* MB; const float* gate;
    __device__ __forceinline__ void operator()(const f32x4 (&acc)[2][2][4][2], const Unit& u, int wr, int wc, int fr, int fq) const {
        const int row0 = u.pm * 256 + wr * 64 + fr, col0 = u.pn * 256 + wc * 32 + 8 * fq;
        const int r = u.pm < 64 ? (u.pm >> 3) : 8;
        const float* gp = gate + r * NMOD + col0;
        f32x4 g[2][2];
#pragma unroll
        for (int bj = 0; bj < 2; ++bj)
#pragma unroll
            for (int n = 0; n < 2; ++n) g[bj][n] = *(const f32x4*)(gp + bj * 128 + 4 * n);
#pragma unroll
        for (int ai = 0; ai < 2; ++ai)
#pragma unroll
            for (int m = 0; m < 4; ++m) {
                bf16_t* rowp = MB + (size_t)(row0 + ai * 128 + m * 16) * DM + col0;
#pragma unroll
                for (int bj = 0; bj < 2; ++bj) {
                    const f32x4 v0 = acc[ai][bj][m][0] * g[bj][0], v1 = acc[ai][bj][m][1] * g[bj][1];
                    u32x4 w; w.x = pg8::cvt_pk_bf16(v0[0], v0[1]); w.y = pg8::cvt_pk_bf16(v0[2], v0[3]); w.z = pg8::cvt_pk_bf16(v1[0], v1[1]); w.w = pg8::cvt_pk_bf16(v1[2], v1[3]);
                    *(u32x4*)(rowp + bj * 128) = w;
                }
            }
    }
};
struct EpiUp {
    static constexpr bool PERM = true, AFTER_DRAIN = false;
    bf16_t* A1; bf16_t* V1;
    __device__ __forceinline__ void operator()(const f32x4 (&acc)[2][2][4][2], const Unit& u, int wr, int wc, int fr, int fq) const {
        const int row0 = u.pm * 256 + wr * 64 + fr, col0 = u.pn * 128 + wc * 32 + 8 * fq;
#pragma unroll
        for (int ai = 0; ai < 2; ++ai)
#pragma unroll
            for (int m = 0; m < 4; ++m) {
                const size_t off = (size_t)(row0 + ai * 128 + m * 16) * DFF + col0;
#pragma unroll
                for (int bj = 0; bj < 2; ++bj) {
                    const f32x4 v0 = acc[ai][bj][m][0], v1 = acc[ai][bj][m][1];
                    u32x4 w; w.x = pg8::cvt_pk_bf16(v0[0], v0[1]); w.y = pg8::cvt_pk_bf16(v0[2], v0[3]); w.z = pg8::cvt_pk_bf16(v1[0], v1[1]); w.w = pg8::cvt_pk_bf16(v1[2], v1[3]);
                    *(u32x4*)((bj ? V1 : A1) + off) = w;
                }
            }
    }
};
__device__ __forceinline__ float dpp_ror1(float x) { return __builtin_bit_cast(float, __builtin_amdgcn_update_dpp(0, __builtin_bit_cast(int, x), 0x121, 0xf, 0xf, false)); }
__device__ __forceinline__ float dpp_rol1(float x) { return __builtin_bit_cast(float, __builtin_amdgcn_update_dpp(0, __builtin_bit_cast(int, x), 0x12F, 0xf, 0xf, false)); }
struct EpiUpFused {
    static constexpr bool PERM = true, AFTER_DRAIN = false;
    bf16_t* HID; float* EA; float* EP; float* EV; const float* cw; const float* cb; float* xch;
    __device__ __forceinline__ void operator()(const f32x4 (&acc)[2][2][4][2], const Unit& u, int wr, int wc, int fr, int fq) const {
        const int lc0 = wc * 32 + 8 * fq, col0 = u.pn * 128 + lc0;
        const int row0 = u.pm * 256 + wr * 64 + fr;
#pragma unroll
        for (int ai = 0; ai < 2; ++ai) {
            const int sg = ai * 2 + wr;
            if (fr == 0) { *(f32x4*)(xch + (sg * 2 + 0) * 128 + lc0) = acc[ai][0][0][0]; *(f32x4*)(xch + (sg * 2 + 0) * 128 + lc0 + 4) = acc[ai][0][0][1]; }
            if (fr == 15) { *(f32x4*)(xch + (sg * 2 + 1) * 128 + lc0) = acc[ai][0][3][0]; *(f32x4*)(xch + (sg * 2 + 1) * 128 + lc0 + 4) = acc[ai][0][3][1]; }
        }
        asm volatile("s_waitcnt lgkmcnt(0)" ::: "memory");
        __builtin_amdgcn_s_barrier();
        asm volatile("" ::: "memory");
        f32x4 w0[2], w1[2], w2[2], bb[2];
#pragma unroll
        for (int n = 0; n < 2; ++n) { w0[n] = *(const f32x4*)(cw + col0 + 4 * n); w1[n] = *(const f32x4*)(cw + DFF + col0 + 4 * n); w2[n] = *(const f32x4*)(cw + 2 * DFF + col0 + 4 * n); bb[n] = *(const f32x4*)(cb + col0 + 4 * n); }
#pragma unroll
        for (int ai = 0; ai < 2; ++ai) {
            const int sg = ai * 2 + wr;
            f32x4 extp[2], extn[2];
#pragma unroll
            for (int n = 0; n < 2; ++n) {
                extp[n] = sg > 0 ? *(const f32x4*)(xch + ((sg - 1) * 2 + 1) * 128 + lc0 + 4 * n) : (f32x4){0.f, 0.f, 0.f, 0.f};
                extn[n] = sg < 3 ? *(const f32x4*)(xch + ((sg + 1) * 2 + 0) * 128 + lc0 + 4 * n) : (f32x4){0.f, 0.f, 0.f, 0.f};
            }
            f32x4 hid[4][2], cvs[4][2];
#pragma unroll
            for (int n = 0; n < 2; ++n)
#pragma unroll
                for (int j = 0; j < 4; ++j) {
                    float a[4], r[4], l[4];
#pragma unroll
                    for (int m = 0; m < 4; ++m) { a[m] = acc[ai][0][m][n][j]; r[m] = dpp_ror1(a[m]); l[m] = dpp_rol1(a[m]); }
#pragma unroll
                    for (int m = 0; m < 4; ++m) {
                        const float pv = fr > 0 ? r[m] : (m > 0 ? r[m > 0 ? m - 1 : 0] : extp[n][j]);
                        const float nv = fr < 15 ? l[m] : (m < 3 ? l[m < 3 ? m + 1 : 3] : extn[n][j]);
                        const float cv = bb[n][j] + pv * w0[n][j] + a[m] * w1[n][j] + nv * w2[n][j];
                        cvs[m][n][j] = cv;
                        hid[m][n][j] = gelu_f(cv) * acc[ai][1][m][n][j];
                    }
                }
#pragma unroll
            for (int m = 0; m < 4; ++m) {
                u32x4 w; w.x = pg8::cvt_pk_bf16(hid[m][0][0], hid[m][0][1]); w.y = pg8::cvt_pk_bf16(hid[m][0][2], hid[m][0][3]); w.z = pg8::cvt_pk_bf16(hid[m][1][0], hid[m][1][1]); w.w = pg8::cvt_pk_bf16(hid[m][1][2], hid[m][1][3]);
                *(u32x4*)(HID + (size_t)(row0 + ai * 128 + m * 16) * DFF + col0) = w;
            }
            if (sg == 0 && fr == 0) {
                const size_t eo = (size_t)(u.pm * 2 + 0) * DFF + col0;
#pragma unroll
                for (int n = 0; n < 2; ++n) { *(f32x4*)(EA + eo + 4 * n) = acc[ai][0][0][n]; *(f32x4*)(EP + eo + 4 * n) = cvs[0][n]; *(f32x4*)(EV + eo + 4 * n) = acc[ai][1][0][n]; }
            }
            if (sg == 3 && fr == 15) {
                const size_t eo = (size_t)(u.pm * 2 + 1) * DFF + col0;
#pragma unroll
                for (int n = 0; n < 2; ++n) { *(f32x4*)(EA + eo + 4 * n) = acc[ai][0][3][n]; *(f32x4*)(EP + eo + 4 * n) = cvs[3][n]; *(f32x4*)(EV + eo + 4 * n) = acc[ai][1][3][n]; }
            }
        }
    }
};
struct EpiH1 {
    static constexpr bool PERM = true, AFTER_DRAIN = false;
    bf16_t* Q1; _Float16* LF; bf16_t* G1; const float* lbraw; int row_off, pn_off;
    __device__ __forceinline__ void operator()(const f32x4 (&acc)[2][2][4][2], const Unit& u, int wr, int wc, int fr, int fq) const {
        const int row0 = row_off + u.pm * 256 + wr * 64 + fr;
        const int pnn = u.pn + pn_off;
        const int seg = pnn >> 3;
        const int cs0 = (pnn & 7) * 256 + wc * 32 + 8 * fq;
        if (seg == 0 || seg == 3) {
            bf16_t* O = seg == 0 ? Q1 : G1;
#pragma unroll
            for (int ai = 0; ai < 2; ++ai)
#pragma unroll
                for (int m = 0; m < 4; ++m) {
                    bf16_t* rowp = O + (size_t)(row0 + ai * 128 + m * 16) * DM + cs0;
#pragma unroll
                    for (int bj = 0; bj < 2; ++bj) {
                        f32x4 v0 = acc[ai][bj][m][0], v1 = acc[ai][bj][m][1];
#pragma unroll
                        for (int j = 0; j < 4; ++j) { v0[j] = silu_f(v0[j]); v1[j] = silu_f(v1[j]); }
                        u32x4 w; w.x = pg8::cvt_pk_bf16(v0[0], v0[1]); w.y = pg8::cvt_pk_bf16(v0[2], v0[3]); w.z = pg8::cvt_pk_bf16(v1[0], v1[1]); w.w = pg8::cvt_pk_bf16(v1[2], v1[3]);
                        *(u32x4*)(rowp + bj * 128) = w;
                    }
                }
        } else {
            const int d = seg - 1;
            _Float16* O = LF + (size_t)d * MTOT * DM;
            float lb[2][8];
#pragma unroll
            for (int bj = 0; bj < 2; ++bj)
#pragma unroll
                for (int e = 0; e < 8; ++e) {
                    const int c = cs0 + bj * 128 + e;
                    lb[bj][e] = sigmoid_f(lbraw[(d * 2 + 1) * DM + c] - lbraw[(d * 2 + 0) * DM + c]);
                }
#pragma unroll
            for (int ai = 0; ai < 2; ++ai)
#pragma unroll
                for (int m = 0; m < 4; ++m) {
                    _Float16* rowp = O + (size_t)(row0 + ai * 128 + m * 16) * DM + cs0;
#pragma unroll
                    for (int bj = 0; bj < 2; ++bj) {
                        h16x8 w;
#pragma unroll
                        for (int e = 0; e < 8; ++e) {
                            const float x = (e < 4) ? acc[ai][bj][m][0][e & 3] : acc[ai][bj][m][1][e & 3];
                            const float f = lb[bj][e] + (1.0f - lb[bj][e]) * sigmoid_f(x);
                            w[e] = (_Float16)__logf(f);
                        }
                        *(h16x8*)(rowp + bj * 128) = w;
                    }
                }
        }
    }
};

#define LDS_WAIT() asm volatile("s_waitcnt lgkmcnt(0)" ::: "memory")
__device__ __forceinline__ void transpose_item(const float* W, int ldw, int k0, int n0, bf16_t* WT, int K, int drow0, float* scr, int lane) {
    f32x4 v[8];
    const int kr = lane >> 3, c4 = (lane & 7) * 4;
#pragma unroll
    for (int i = 0; i < 8; ++i) v[i] = *(const f32x4*)(W + (size_t)(k0 + kr + 8 * i) * ldw + n0 + c4);
#pragma unroll
    for (int i = 0; i < 8; ++i) { float* s = scr + (kr + 8 * i) * 33 + c4; s[0] = v[i][0]; s[1] = v[i][1]; s[2] = v[i][2]; s[3] = v[i][3]; }
    LDS_WAIT(); asm volatile("" ::: "memory");
    const int c = lane & 7;
#pragma unroll
    for (int j = 0; j < 4; ++j) { const int n = (lane >> 3) + 8 * j; const float* s = scr + (8 * c) * 33 + n;
        u32x4 o; o.x = pk2(s[0 * 33], s[1 * 33]); o.y = pk2(s[2 * 33], s[3 * 33]); o.z = pk2(s[4 * 33], s[5 * 33]); o.w = pk2(s[6 * 33], s[7 * 33]);
        *(u32x4*)(WT + (size_t)(drow0 + n) * K + k0 + 8 * c) = o; }
    LDS_WAIT(); asm volatile("" ::: "memory");
}
struct TJob { const float* W; int ldw, K, ncols, col0; bf16_t* WT; int mode; };
__device__ __forceinline__ int tjob_items(const TJob& j) { return (j.K / 64) * (j.ncols / 32); }
__device__ __forceinline__ void tjob_run(const TJob& j, int drow_base, int it, float* scr, int lane) {
    const int nblk = j.ncols / 32, kb = it / nblk, nb = it % nblk;
    const int n = nb * 32;
    int drow;
    if (j.mode == 0) drow = drow_base + n;
    else { const int bj = n / DFF, r = n % DFF, pn = r >> 7, i = r & 127; drow = 256 * pn + 128 * bj + i; }
    transpose_item(j.W, j.ldw, kb * 64, j.col0 + n, j.WT, j.K, drow, scr, lane);
}

__device__ __forceinline__ void row_op(const float* zrow, float* hrow, const float* g, const float* bt, bool ln1, const float* sh, const float* sc, bf16_t* urow, int lane, const bf16_t* mrow = nullptr, const f32x4* gpre = nullptr, const f32x4* bpre = nullptr) {
    f32x4 v[8];
    const f32x4* zr = (const f32x4*)zrow + lane;
#pragma unroll
    for (int j = 0; j < 8; ++j) v[j] = zr[64 * j];
    f32x4 scv[8], shv[8];
    if (urow) {
#pragma unroll
        for (int j = 0; j < 8; ++j) { scv[j] = *((const f32x4*)sc + lane + 64 * j); shv[j] = *((const f32x4*)sh + lane + 64 * j); }
    }
    if (mrow) {
#pragma unroll
        for (int j = 0; j < 8; ++j) {
            const u32x2 mw = *((const u32x2*)mrow + lane + 64 * j);
            v[j][0] = v[j][0] * ALPHA_F + bf2f((unsigned short)(mw.x & 0xffffu)); v[j][1] = v[j][1] * ALPHA_F + bf2f((unsigned short)(mw.x >> 16));
            v[j][2] = v[j][2] * ALPHA_F + bf2f((unsigned short)(mw.y & 0xffffu)); v[j][3] = v[j][3] * ALPHA_F + bf2f((unsigned short)(mw.y >> 16));
        }
    }
    if (ln1) {
        float s = 0.f;
#pragma unroll
        for (int j = 0; j < 8; ++j) s += (v[j][0] + v[j][1]) + (v[j][2] + v[j][3]);
        const float mean = wave_sum(s) * (1.f / DM); float s2 = 0.f;
#pragma unroll
        for (int j = 0; j < 8; ++j) { v[j] = v[j] - mean; s2 += (v[j][0] * v[j][0] + v[j][1] * v[j][1]) + (v[j][2] * v[j][2] + v[j][3] * v[j][3]); }
        const float rstd = 1.f / sqrtf(wave_sum(s2) * (1.f / DM) + LN_EPS_F);
#pragma unroll
        for (int j = 0; j < 8; ++j) { const f32x4 gg = gpre ? gpre[j] : *((const f32x4*)g + lane + 64 * j), bb = bpre ? bpre[j] : *((const f32x4*)bt + lane + 64 * j); v[j] = v[j] * rstd * gg + bb; }
        if (hrow) {
#pragma unroll
            for (int j = 0; j < 8; ++j) *((f32x4*)hrow + lane + 64 * j) = v[j];
        }
    }
    if (urow) {
        float s = 0.f;
#pragma unroll
        for (int j = 0; j < 8; ++j) s += (v[j][0] + v[j][1]) + (v[j][2] + v[j][3]);
        const float mean = wave_sum(s) * (1.f / DM); float s2 = 0.f;
#pragma unroll
        for (int j = 0; j < 8; ++j) { v[j] = v[j] - mean; s2 += (v[j][0] * v[j][0] + v[j][1] * v[j][1]) + (v[j][2] * v[j][2] + v[j][3] * v[j][3]); }
        const float rstd = 1.f / sqrtf(wave_sum(s2) * (1.f / DM) + LN_EPS_F);
#pragma unroll
        for (int j = 0; j < 8; ++j) {
            const f32x4 o = v[j] * rstd * (scv[j] + 1.0f) + shv[j];
            u32x2 w; w.x = pk2(o[0], o[1]); w.y = pk2(o[2], o[3]);
            *((u32x2*)urow + lane + 64 * j) = w;
        }
    }
}

__device__ __forceinline__ void attn_unit(unsigned char* lds, const bf16_t* QK, const bf16_t* VT0, bf16_t* CAT, const float* subln, float lam, int unit) {
    int tid_ = threadIdx.x; asm volatile("" : "+v"(tid_)); const int tid = tid_, lane = tid & 63, wave = tid >> 6, fr = lane & 15, fq = lane >> 4;
    const int qg = wave >> 1, sm = wave & 1;
    int b, h, qrow0, ntiles;
    int rot = 0;
    if (unit < 1536) { b = unit / 192; const int rem = unit % 192; h = rem >> 4; qrow0 = b * SEQ + (rem & 15) * 128; ntiles = 36; rot = ((rem & 15) * 9) >> 2; }
    else { const int uu = unit - 1536; b = uu / 24; const int rem = uu % 24; h = rem >> 1; qrow0 = MLAT + b * CTXL + (rem & 1) * 128; ntiles = 4; }
    bf16_t* Kt0 = (bf16_t*)lds;
    float* XO = (float*)lds;
    bf16x8 q[2][2];
#pragma unroll
    for (int qt = 0; qt < 2; ++qt)
#pragma unroll
        for (int kk = 0; kk < 2; ++kk)
            q[qt][kk] = *(const bf16x8*)(QK + (size_t)(qrow0 + qg * 32 + qt * 16 + fr) * 3072 + h * 128 + sm * 64 + kk * 32 + fq * 8);
    f32x4 O[2][8];
#pragma unroll
    for (int qt = 0; qt < 2; ++qt)
#pragma unroll
        for (int dt = 0; dt < 8; ++dt) O[qt][dt] = (f32x4){0.f, 0.f, 0.f, 0.f};
    float mrun[2] = {-INFINITY, -INFINITY}, lrun[2] = {0.f, 0.f};
    u32x4 kreg[2], vreg[2];
#define keyrow_(i) ((i) < 4 ? (MLAT + b * CTXL + 64 * (i)) : (b * SEQ + 64 * ((i) - 4)))
#define keyrow(i) keyrow_(((i) + rot) % ntiles)
#define AT_LOAD(i_) do { const int kr0 = keyrow(i_); _Pragma("unroll") for (int c = 0; c < 2; ++c) { const int id = tid + 512 * c; \
            kreg[c] = *(const u32x4*)(QK + (size_t)(kr0 + (id >> 4)) * 3072 + 1536 + h * 128 + (id & 15) * 8); \
            vreg[c] = *(const u32x4*)(VT0 + (size_t)(h * 128 + (id >> 3)) * MTOT + kr0 + (id & 7) * 8); } } while (0)
#define AT_STORE(buf_) do { bf16_t* Kb = Kt0 + (buf_) * 18432; bf16_t* Vb = Kb + 8704; _Pragma("unroll") for (int c = 0; c < 2; ++c) { const int id = tid + 512 * c; \
            *(u32x4*)(Kb + (id >> 4) * 136 + (id & 15) * 8) = kreg[c]; \
            *(u32x4*)(Vb + (id >> 3) * 72 + (id & 7) * 8) = vreg[c]; } } while (0)
    __syncthreads();
    AT_LOAD(0); AT_STORE(0);
    if (ntiles > 1) AT_LOAD(1);
    __syncthreads();
    const bool grpB = wave >= 4;
    bf16x8 pb[2][2];
#define AT_PV(Vt_) do { _Pragma("unroll") for (int hf = 0; hf < 2; ++hf) { bf16x8 av_[8]; \
        _Pragma("unroll") for (int d4 = 0; d4 < 4; ++d4) _Pragma("unroll") for (int kk = 0; kk < 2; ++kk) { const int dt = hf * 4 + d4; \
            const u32x2 lo = *(const u32x2*)((Vt_) + (dt * 16 + fr) * 72 + kk * 32 + 4 * fq); \
            const u32x2 hi = *(const u32x2*)((Vt_) + (dt * 16 + fr) * 72 + kk * 32 + 16 + 4 * fq); \
            u32x4 w; w.x = lo.x; w.y = lo.y; w.z = hi.x; w.w = hi.y; av_[d4 * 2 + kk] = __builtin_bit_cast(bf16x8, w); } \
        __builtin_amdgcn_sched_barrier(0); \
        _Pragma("unroll") for (int d4 = 0; d4 < 4; ++d4) _Pragma("unroll") for (int kk = 0; kk < 2; ++kk) \
            _Pragma("unroll") for (int qt = 0; qt < 2; ++qt) O[qt][hf * 4 + d4] = __builtin_amdgcn_mfma_f32_16x16x32_bf16(av_[d4 * 2 + kk], pb[qt][kk], O[qt][hf * 4 + d4], 0, 0, 0); \
        __builtin_amdgcn_sched_barrier(0); } } while (0)
    int rb = 0;
    for (int i = 0; i <= ntiles; ++i) {
        const int rbn = rb == 2 ? 0 : rb + 1, rbp = rb == 0 ? 2 : rb - 1;
        const bf16_t* Kt = Kt0 + rb * 18432;
        if (i + 1 < ntiles) AT_STORE(rbn);
        if (i + 2 < ntiles) AT_LOAD(i + 2);
        if (grpB && i > 0) AT_PV(Kt0 + rbp * 18432 + 8704);
        if (i < ntiles) {
        f32x4 s[4][2];
#pragma unroll
        for (int kt = 0; kt < 4; ++kt) {
            const bf16x8 a0 = *(const bf16x8*)(Kt + (kt * 16 + fr) * 136 + sm * 64 + fq * 8);
            const bf16x8 a1 = *(const bf16x8*)(Kt + (kt * 16 + fr) * 136 + sm * 64 + 32 + fq * 8);
#pragma unroll
            for (int qt = 0; qt < 2; ++qt) {
                f32x4 z = {0.f, 0.f, 0.f, 0.f};
                z = __builtin_amdgcn_mfma_f32_16x16x32_bf16(a0, q[qt][0], z, 0, 0, 0);
                s[kt][qt] = __builtin_amdgcn_mfma_f32_16x16x32_bf16(a1, q[qt][1], z, 0, 0, 0);
            }
        }
#pragma unroll
        for (int qt = 0; qt < 2; ++qt) {
            float mx = -INFINITY;
#pragma unroll
            for (int kt = 0; kt < 4; ++kt)
#pragma unroll
                for (int j = 0; j < 4; ++j) mx = fmaxf(mx, s[kt][qt][j]);
            if (__builtin_amdgcn_ballot_w64(mx > mrun[qt] + 40.0f) != 0ull) {
                mx = fmaxf(mx, __shfl_xor(mx, 16)); mx = fmaxf(mx, __shfl_xor(mx, 32));
                const float mnew = fmaxf(mrun[qt], mx);
                const float alpha = __builtin_amdgcn_exp2f(mrun[qt] - mnew);
                mrun[qt] = mnew;
                lrun[qt] = lrun[qt] * alpha;
#pragma unroll
                for (int dt = 0; dt < 8; ++dt) O[qt][dt] = O[qt][dt] * alpha;
            }
            const float mnew = mrun[qt];
            float ls = 0.f;
#pragma unroll
            for (int kt = 0; kt < 4; ++kt)
#pragma unroll
                for (int j = 0; j < 4; ++j) { const float p = __builtin_amdgcn_exp2f(s[kt][qt][j] - mnew); s[kt][qt][j] = p; ls += p; }
            lrun[qt] += ls;
#pragma unroll
            for (int kk = 0; kk < 2; ++kk) {
                u32x4 w; w.x = pg8::cvt_pk_bf16(s[2 * kk][qt][0], s[2 * kk][qt][1]); w.y = pg8::cvt_pk_bf16(s[2 * kk][qt][2], s[2 * kk][qt][3]);
                w.z = pg8::cvt_pk_bf16(s[2 * kk + 1][qt][0], s[2 * kk + 1][qt][1]); w.w = pg8::cvt_pk_bf16(s[2 * kk + 1][qt][2], s[2 * kk + 1][qt][3]);
                pb[qt][kk] = __builtin_bit_cast(bf16x8, w);
            }
        }
        if (!grpB) AT_PV(Kt + 8704);
        }
        rb = rbn;
        __syncthreads();
    }
#undef AT_PV
#undef AT_LOAD
#undef AT_STORE
    float inv[2];
#pragma unroll
    for (int qt = 0; qt < 2; ++qt) { float l = lrun[qt]; l += __shfl_xor(l, 16); l += __shfl_xor(l, 32); inv[qt] = 1.0f / l; }
    __syncthreads();
    if (sm == 1) {
#pragma unroll
        for (int qt = 0; qt < 2; ++qt)
#pragma unroll
            for (int dt = 0; dt < 8; ++dt)
#pragma unroll
                for (int j = 0; j < 4; ++j) XO[(qg * 64 + (qt * 8 + dt) * 4 + j) * 64 + lane] = O[qt][dt][j] * inv[qt];
    }
    __syncthreads();
    if (sm == 0) {
#pragma unroll
        for (int qt = 0; qt < 2; ++qt) {
            float ss = 0.f;
#pragma unroll
            for (int dt = 0; dt < 8; ++dt)
#pragma unroll
                for (int j = 0; j < 4; ++j) { const float o = O[qt][dt][j] * inv[qt] - lam * XO[(qg * 64 + (qt * 8 + dt) * 4 + j) * 64 + lane]; O[qt][dt][j] = o; ss += o * o; }
            ss += __shfl_xor(ss, 16); ss += __shfl_xor(ss, 32);
            const float r = (1.0f - LAM_INIT0) / sqrtf(ss * (1.0f / 128.0f) + RMS_EPS_F);
            bf16_t* rowp = CAT + (size_t)(qrow0 + qg * 32 + qt * 16 + fr) * 2048 + h * 128 + 4 * fq;
#pragma unroll
            for (int dt = 0; dt < 8; ++dt) {
                const f32x4 w4 = *(const f32x4*)(subln + dt * 16 + 4 * fq);
                u32x2 w; w.x = pk2(O[qt][dt][0] * r * w4[0], O[qt][dt][1] * r * w4[1]); w.y = pk2(O[qt][dt][2] * r * w4[2], O[qt][dt][3] * r * w4[3]);
                *(u32x2*)(rowp + dt * 16) = w;
            }
        }
    }
}

constexpr int SC_RAWQ = 0, SC_RAWLF = 16384, SC_RAWVT = 32768, SC_PREP = 63488, SC_PREP_SZ = 36864;
constexpr int SP_QI = 0, SP_QR = 8704, SP_KR = 17408, SP_KET = 26112, SP_DEC = 36352;
#define chunk_row0(ci) ((ci) < 8 ? (MLAT + b * CTXL + 32 * (dir ? 7 - (ci) : (ci))) : (b * SEQ + 32 * (dir ? 63 - ((ci) - 8) : ((ci) - 8))))
template <int G_, int DIR_>
__device__ __forceinline__ void scan_elem_t(unsigned char* lds, int ci, int k) {
    const int cur = ci & 1; const bool need_out = ci >= 8;
    const bf16_t* rawq = (const bf16_t*)(lds + SC_RAWQ + cur * 8192) + k;
    const _Float16* rawlf = (const _Float16*)(lds + SC_RAWLF + cur * 8192) + k;
    unsigned char* pb = lds + SC_PREP + cur * SC_PREP_SZ;
    bf16_t* QI = (bf16_t*)(pb + SP_QI) + k; bf16_t* QR = (bf16_t*)(pb + SP_QR) + k; bf16_t* KR = (bf16_t*)(pb + SP_KR) + k; bf16_t* KET = (bf16_t*)(pb + SP_KET); float* DEC = (float*)(pb + SP_DEC);
    float run = 0.f, ref = 0.f, cums[8], lfv[8];
#pragma unroll
    for (int p = 0; p < 32; ++p) {
        const int i = DIR_ ? 31 - p : p;
        const float x = (float)rawlf[i * 128];
        run += x;
        if ((p >> 3) == G_) { cums[p & 7] = run; lfv[p & 7] = x; }
        if (p == 15) ref = run;
    }
    const float tot = run;
    const float E1 = __expf(fminf(-ref, 80.f)), E2 = __expf(fminf(ref - tot, 80.f));
    float ket[8], ec[8];
#pragma unroll
    for (int e = 0; e < 8; ++e) { ket[e] = (1.0f - __expf(lfv[e])) * __expf(tot - cums[e]); ec[e] = __expf(cums[e]); }
    if (need_out) {
#pragma unroll
        for (int e = 0; e < 8; e += 2) {
            const int p0 = 8 * G_ + e, i0 = DIR_ ? 31 - p0 : p0, i1 = DIR_ ? i0 - 1 : i0 + 1;
            const float qa = bf2f(rawq[i0 * 128]) * ec[e], qb = bf2f(rawq[i1 * 128]) * ec[e + 1];
            const unsigned wi = pg8::cvt_pk_bf16(qa, qb), wr_ = pg8::cvt_pk_bf16(qa * E1, qb * E1), wk = pg8::cvt_pk_bf16(ket[e] * E2, ket[e + 1] * E2);
            QI[i0 * 136] = (bf16_t)(wi & 0xffffu); QI[i1 * 136] = (bf16_t)(wi >> 16);
            QR[i0 * 136] = (bf16_t)(wr_ & 0xffffu); QR[i1 * 136] = (bf16_t)(wr_ >> 16);
            KR[i0 * 136] = (bf16_t)(wk & 0xffffu); KR[i1 * 136] = (bf16_t)(wk >> 16);
        }
    }
    u32x4 wv;
    if (DIR_) { wv.x = pg8::cvt_pk_bf16(ket[7], ket[6]); wv.y = pg8::cvt_pk_bf16(ket[5], ket[4]); wv.z = pg8::cvt_pk_bf16(ket[3], ket[2]); wv.w = pg8::cvt_pk_bf16(ket[1], ket[0]); }
    else      { wv.x = pg8::cvt_pk_bf16(ket[0], ket[1]); wv.y = pg8::cvt_pk_bf16(ket[2], ket[3]); wv.z = pg8::cvt_pk_bf16(ket[4], ket[5]); wv.w = pg8::cvt_pk_bf16(ket[6], ket[7]); }
    const int i0 = DIR_ ? 24 - 8 * G_ : 8 * G_;
    *(u32x4*)(KET + k * 40 + i0) = wv;
    if (G_ == 0) DEC[k] = __expf(tot);
}
__device__ __forceinline__ void scan_elem(unsigned char* lds, int ci, int dir, int k, int g) {
    const int sel = __builtin_amdgcn_readfirstlane(g * 2 + dir);
    switch (sel) {
        case 0: scan_elem_t<0, 0>(lds, ci, k); break;
        case 1: scan_elem_t<0, 1>(lds, ci, k); break;
        case 2: scan_elem_t<1, 0>(lds, ci, k); break;
        case 3: scan_elem_t<1, 1>(lds, ci, k); break;
        case 4: scan_elem_t<2, 0>(lds, ci, k); break;
        case 5: scan_elem_t<2, 1>(lds, ci, k); break;
        case 6: scan_elem_t<3, 0>(lds, ci, k); break;
        default: scan_elem_t<3, 1>(lds, ci, k); break;
    }
}
__device__ __forceinline__ void scan_mfma(unsigned char* lds, f32x4 (&S)[8], int ci, int vt3, int dir, int r0, bf16_t* Od, int h, int w, int fr, int fq) {
    const int cur = ci & 1; const bool need_out = ci >= 8;
    const bf16_t* rawvt = (const bf16_t*)(lds + SC_RAWVT + vt3 * 10240);
    unsigned char* pb = lds + SC_PREP + cur * SC_PREP_SZ;
    const bf16_t* QI = (const bf16_t*)(pb + SP_QI); const bf16_t* QR = (const bf16_t*)(pb + SP_QR); const bf16_t* KR = (const bf16_t*)(pb + SP_KR); const bf16_t* KET = (const bf16_t*)(pb + SP_KET); const float* DEC = (const float*)(pb + SP_DEC);
    if (need_out) {
        f32x4 sc[2][2];
#pragma unroll
        for (int st = 0; st < 2; ++st)
#pragma unroll
            for (int tt = 0; tt < 2; ++tt) {
                f32x4 z = {0.f, 0.f, 0.f, 0.f};
#pragma unroll
                for (int kk = 0; kk < 4; ++kk) {
                    const bf16x8 a = *(const bf16x8*)(KR + (st * 16 + fr) * 136 + kk * 32 + fq * 8);
                    const bf16x8 bq = *(const bf16x8*)(QR + (tt * 16 + fr) * 136 + kk * 32 + fq * 8);
                    z = __builtin_amdgcn_mfma_f32_16x16x32_bf16(a, bq, z, 0, 0, 0);
                }
#pragma unroll
                for (int j = 0; j < 4; ++j) { const int s_ = st * 16 + 4 * fq + j, t_ = tt * 16 + fr; const bool ok = dir ? (s_ >= t_) : (s_ <= t_); z[j] = ok ? z[j] : 0.f; }
                sc[st][tt] = z;
            }
        bf16x8 Sb[4];
#pragma unroll
        for (int kk = 0; kk < 4; ++kk) {
            u32x4 wv; wv.x = pg8::cvt_pk_bf16(S[2 * kk][0], S[2 * kk][1]); wv.y = pg8::cvt_pk_bf16(S[2 * kk][2], S[2 * kk][3]);
            wv.z = pg8::cvt_pk_bf16(S[2 * kk + 1][0], S[2 * kk + 1][1]); wv.w = pg8::cvt_pk_bf16(S[2 * kk + 1][2], S[2 * kk + 1][3]);
            Sb[kk] = __builtin_bit_cast(bf16x8, wv);
        }
        const u32x2 vlo = *(const u32x2*)(rawvt + (16 * w + fr) * 40 + 4 * fq);
        const u32x2 vhi = *(const u32x2*)(rawvt + (16 * w + fr) * 40 + 16 + 4 * fq);
        u32x4 vw; vw.x = vlo.x; vw.y = vlo.y; vw.z = vhi.x; vw.w = vhi.y;
        const bf16x8 bv = __builtin_bit_cast(bf16x8, vw);
#pragma unroll
        for (int tt = 0; tt < 2; ++tt) {
            u32x4 pw; pw.x = pg8::cvt_pk_bf16(sc[0][tt][0], sc[0][tt][1]); pw.y = pg8::cvt_pk_bf16(sc[0][tt][2], sc[0][tt][3]);
            pw.z = pg8::cvt_pk_bf16(sc[1][tt][0], sc[1][tt][1]); pw.w = pg8::cvt_pk_bf16(sc[1][tt][2], sc[1][tt][3]);
            f32x4 o = {0.f, 0.f, 0.f, 0.f}, o2 = {0.f, 0.f, 0.f, 0.f};
            o = __builtin_amdgcn_mfma_f32_16x16x32_bf16(__builtin_bit_cast(bf16x8, pw), bv, o, 0, 0, 0);
#pragma unroll
            for (int kk = 0; kk < 4; ++kk) {
                const u32x2 alo = *(const u32x2*)(QI + (tt * 16 + fr) * 136 + kk * 32 + 4 * fq);
                const u32x2 ahi = *(const u32x2*)(QI + (tt * 16 + fr) * 136 + kk * 32 + 16 + 4 * fq);
                u32x4 aw; aw.x = alo.x; aw.y = alo.y; aw.z = ahi.x; aw.w = ahi.y;
                if (kk & 1) o2 = __builtin_amdgcn_mfma_f32_16x16x32_bf16(__builtin_bit_cast(bf16x8, aw), Sb[kk], o2, 0, 0, 0);
                else        o  = __builtin_amdgcn_mfma_f32_16x16x32_bf16(__builtin_bit_cast(bf16x8, aw), Sb[kk], o, 0, 0, 0);
            }
            o = o + o2;
#pragma unroll
            for (int j = 0; j < 4; ++j) Od[(size_t)(r0 + tt * 16 + 4 * fq + j) * DM + h * 128 + 16 * w + fr] = (bf16_t)f2bf(o[j]);
        }
    }
    const bf16x8 bvt = *(const bf16x8*)(rawvt + (16 * w + fr) * 40 + fq * 8);
#pragma unroll
    for (int i = 0; i < 8; ++i) {
        const f32x4 dec = *(const f32x4*)(DEC + 16 * i + 4 * fq);
        const bf16x8 a = *(const bf16x8*)(KET + (16 * i + fr) * 40 + fq * 8);
        S[i] = __builtin_amdgcn_mfma_f32_16x16x32_bf16(a, bvt, S[i] * dec, 0, 0, 0);
    }
}
__device__ __forceinline__ void scan_chain(unsigned char* lds, const bf16_t* Q1, const _Float16* LFd, const bf16_t* VT1, bf16_t* Od, int b, int h, int dir) {
    int tid_ = threadIdx.x; asm volatile("" : "+v"(tid_)); const int tid = tid_, lane = tid & 63, w = tid >> 6, fr = lane & 15, fq = lane >> 4;
    const int k = tid & 127, g = tid >> 7;
    f32x4 S[8];
#pragma unroll
    for (int i = 0; i < 8; ++i) S[i] = (f32x4){0.f, 0.f, 0.f, 0.f};
    u32x4 rq, rl, rv;
#define SC_LOAD(ci_) do { const int r_ = chunk_row0(ci_); \
        rq = *(const u32x4*)(Q1 + (size_t)(r_ + (tid >> 4)) * DM + h * 128 + (tid & 15) * 8); \
        rl = *(const u32x4*)(LFd + (size_t)(r_ + (tid >> 4)) * DM + h * 128 + (tid & 15) * 8); \
        rv = *(const u32x4*)(VT1 + (size_t)(h * 128 + (tid >> 2)) * MTOT + r_ + (tid & 3) * 8); } while (0)
#define SC_STORE(par_, v3_) do { \
        *(u32x4*)(lds + SC_RAWQ + (par_) * 8192 + (tid >> 4) * 256 + (tid & 15) * 16) = rq; \
        *(u32x4*)(lds + SC_RAWLF + (par_) * 8192 + (tid >> 4) * 256 + (tid & 15) * 16) = rl; \
        *(u32x4*)(lds + SC_RAWVT + (v3_) * 10240 + (tid >> 2) * 80 + (tid & 3) * 16) = rv; } while (0)
    SC_LOAD(0); SC_STORE(0, 0);
    SC_LOAD(1); SC_STORE(1, 1);
    __syncthreads();
    scan_elem(lds, 0, dir, k, g);
    __syncthreads();
    int v3 = 0;
    for (int ci = 0; ci < 72; ++ci) {
        const int r0 = chunk_row0(ci);
        if (ci + 2 < 72) SC_LOAD(ci + 2);
        scan_mfma(lds, S, ci, v3, dir, r0, Od, h, w, fr, fq);
        if (ci + 1 < 72) scan_elem(lds, ci + 1, dir, k, g);
        const int v3n = v3 == 0 ? 2 : v3 - 1;
        if (ci + 2 < 72) SC_STORE(ci & 1, v3n);
        v3 = v3 == 2 ? 0 : v3 + 1;
        __syncthreads();
    }
#undef SC_LOAD
#undef SC_STORE
}

#define LAS __attribute__((address_space(3)))
#define XB_TMO      128
#define XB_XCNT(j)  (256  + 64 * (j))
#define XB_XSUB(j)  (1280 + 64 * (j))
#define XB_XGEN(j)  (2304 + 64 * (j))
#define XB_TOP      3328
#define XB_TOPGEN   3392
#define XCD_BAR_WORDS 3456
#define XB_SPIN_CAP (1u << 18)

__device__ __forceinline__ unsigned xb_ld(unsigned* p)              { return __hip_atomic_load(p, __ATOMIC_RELAXED, __HIP_MEMORY_SCOPE_AGENT); }
__device__ __forceinline__ unsigned xb_add(unsigned* p, unsigned v) { return __hip_atomic_fetch_add(p, v, __ATOMIC_RELAXED, __HIP_MEMORY_SCOPE_AGENT); }
__device__ __forceinline__ unsigned xb_xcc_id() { return (unsigned)__builtin_amdgcn_s_getreg((3 << 11) | 20) & 0xFu; }
#define XB_SPIN(cond, bar) do { unsigned _sp = 0; while (cond) { __builtin_amdgcn_s_sleep(1); \
    if ((++_sp & 255u) == 0u) { if (xb_ld(&(bar)[XB_TMO])) break; if (_sp > XB_SPIN_CAP) { atomicAdd(&(bar)[XB_TMO], 1u); break; } } } } while (0)

struct XcdBarrier {
    unsigned* bar; unsigned x;
    volatile LAS unsigned* st;
};

__device__ __forceinline__ XcdBarrier xcd_barrier_post(unsigned* bar, volatile LAS unsigned* st) {
    XcdBarrier b; b.bar = bar; b.x = xb_xcc_id(); b.st = st;
    if (threadIdx.x == 0) (void)xb_add(&bar[XB_XCNT(b.x)], 1u);
    return b;
}
__device__ __forceinline__ void xcd_barrier_complete(unsigned* bar, unsigned x, unsigned& nloc, unsigned& nx) {
    const unsigned G = gridDim.x * gridDim.y * gridDim.z;
    unsigned sum, cnt, mine, sp = 0u;
    for (;;) {
        sum = 0u; cnt = 0u; mine = 0u;
#pragma unroll
        for (unsigned j = 0; j < 16; ++j) { const unsigned c = xb_ld(&bar[XB_XCNT(j)]); sum += c; cnt += (c > 0u) ? 1u : 0u; mine = (j == x) ? c : mine; }
        if (sum == G) break;
        __builtin_amdgcn_s_sleep(1);
        if ((++sp & 255u) == 0u) { if (xb_ld(&bar[XB_TMO])) break; if (sp > XB_SPIN_CAP) { atomicAdd(&bar[XB_TMO], 1u); break; } }
    }
    nloc = mine > 0u ? mine : 1u; nx = cnt > 0u ? cnt : 1u;
}

__device__ __forceinline__ void xcd_barrier(const XcdBarrier& b) {
    asm volatile("s_waitcnt vmcnt(0)" ::: "memory");
    __syncthreads();
    if (threadIdx.x == 0) {
        unsigned* bar = b.bar;
        __builtin_amdgcn_s_waitcnt(0);
        unsigned nloc = b.st[0], nx = b.st[1];
        if (nloc == 0u) { xcd_barrier_complete(bar, b.x, nloc, nx); b.st[0] = nloc; b.st[1] = nx; }
        const unsigned old = xb_add(&bar[XB_XSUB(b.x)], 1u);
        const unsigned gen = old / nloc;
        if (old + 1u == (gen + 1u) * nloc) {
            __builtin_amdgcn_fence(__ATOMIC_RELEASE, "agent");
            asm volatile("s_waitcnt vmcnt(0)" ::: "memory");
            const unsigned og = xb_add(&bar[XB_TOP], 1u);
            const unsigned tg = og / nx;
            if (og + 1u == (tg + 1u) * nx) xb_add(&bar[XB_TOPGEN], 1u);
            else XB_SPIN(xb_ld(&bar[XB_TOPGEN]) == tg, bar);
            __builtin_amdgcn_fence(__ATOMIC_ACQUIRE, "agent");
            xb_add(&bar[XB_XGEN(b.x)], 1u);
            asm volatile("s_waitcnt vmcnt(0)" ::: "memory");
        } else {
            XB_SPIN(xb_ld(&bar[XB_XGEN(b.x)]) == gen, bar);
            __builtin_amdgcn_fence(__ATOMIC_ACQUIRE, "agent");
            asm volatile("s_waitcnt vmcnt(0)" ::: "memory");
        }
    }
    __syncthreads();
}

__global__ void __launch_bounds__(512, 2) hybrid_fwd(Args args) {
    extern __shared__ __attribute__((aligned(16))) unsigned char lds[];
    cg::grid_group grid = cg::this_grid();
    const int tid = threadIdx.x, lane = tid & 63, wave = __builtin_amdgcn_readfirstlane(tid >> 6);
    const int G = gridDim.x, bid = blockIdx.x;
    const int gw = bid * 8 + wave, NGW = G * 8;
    unsigned char* ws = args.ws;
    PG8_LAS unsigned char* ldsg = (PG8_LAS unsigned char*)lds;

    const float* x = args.in[0]; const float* cvec = args.in[1]; const float* ctx = args.in[2]; const float* c_ctx = args.in[3];
    const float* mod_w = args.in[4]; const float* mod_b = args.in[5];
    const float* ln_mix_g = args.in[6]; const float* ln_mix_b = args.in[7]; const float* ln_ffn_g = args.in[8]; const float* ln_ffn_b = args.in[9];
    const float* even_w_in = args.in[10]; const float* even_w_out = args.in[11]; const float* diff_lambda = args.in[12]; const float* diff_subln = args.in[13];
    const float* hgrn_w_in = args.in[14]; const float* hgrn_w_out = args.in[15]; const float* hgrn_lb = args.in[16]; const float* hgrn_norm = args.in[17];
    const float* ffn_w_up = args.in[18]; const float* ffn_conv_w = args.in[19]; const float* ffn_conv_b = args.in[20]; const float* ffn_w_down = args.in[21];
    float* hlat = args.out;
    float* hctx = (float*)(ws + WS_HCTX);
    float* modv = (float*)(ws + WS_MODV);
    float* rope = (float*)(ws + WS_ROPE);
    bf16_t* U = (bf16_t*)(ws + WS_U);
    unsigned* ctl = (unsigned*)(ws + WS_CTL);
    if (tid < 64) ((volatile LAS unsigned*)((LAS unsigned char*)lds + LDS_MISC))[tid] = 0u;
    __syncthreads();
    const XcdBarrier xbar = xcd_barrier_post(ctl + 1024, (volatile LAS unsigned*)((LAS unsigned char*)lds + LDS_MISC + 32));
#define GRID_BAR() xcd_barrier(xbar)

    for (int rep = 0; rep < (PROBE == 3 ? 2 : 1); ++rep) {
        if (bid == 0) {
            for (int e = tid; e < 1024; e += 512) {
                const int pos = e >> 4, i = e & 15;
                const float inv = 1.0f / powf(10000.0f, (float)(2 * i) / 32.0f);
                const float ang = (float)pos * inv;
                rope[e] = cosf(ang); rope[1024 + e] = sinf(ang);
            }
        }
        {
            float* sl = (float*)lds;
            float* red = (float*)(lds + 81920);
            for (int e = tid; e < 9 * DM; e += 512) { const int r = e >> 11, kk = e & 2047; const float v = r < 8 ? cvec[r * DM + kk] : c_ctx[kk]; sl[e] = silu_f(v); }
            __syncthreads();
            const int cg4 = tid & 7, kg = tid >> 3;
            float* red2 = (float*)(lds + 81920);
            for (int it = bid; it < 768; it += G) {
                const int l = it / 384, n0 = (it % 384) * 32;
                const float* wp = mod_w + (size_t)l * DM * NMOD + (size_t)(kg * 32) * NMOD + n0 + cg4 * 4;
                f32x4 a[9];
#pragma unroll
                for (int r = 0; r < 9; ++r) a[r] = (f32x4){0.f, 0.f, 0.f, 0.f};
#pragma unroll 8
                for (int kk = 0; kk < 32; ++kk) {
                    const f32x4 wv = *(const f32x4*)(wp + (size_t)kk * NMOD);
#pragma unroll
                    for (int r = 0; r < 9; ++r) a[r] += wv * sl[r * DM + kg * 32 + kk];
                }
#pragma unroll
                for (int r = 0; r < 9; ++r)
#pragma unroll
                    for (int j = 0; j < 4; ++j) { float t = a[r][j]; t += __shfl_xor(t, 8); t += __shfl_xor(t, 16); t += __shfl_xor(t, 32); a[r][j] = t; }
                if (lane < 8) {
#pragma unroll
                    for (int r = 0; r < 9; ++r) *(f32x4*)(red2 + (wave * 9 + r) * 32 + lane * 4) = a[r];
                }
                __syncthreads();
                if (tid < 288) {
                    const int r = tid >> 5, c2 = tid & 31; float s = 0.f;
#pragma unroll
                    for (int q2 = 0; q2 < 8; ++q2) s += red2[(q2 * 9 + r) * 32 + c2];
                    modv[(size_t)(l * 9 + r) * NMOD + n0 + c2] = s + mod_b[l * NMOD + n0 + c2];
                }
                __syncthreads();
            }
        }
        {
            bf16_t* D2 = (bf16_t*)(ws + WS_D2);
            for (size_t e = (size_t)bid * 512 + tid; e < (size_t)2048 * 512; e += (size_t)G * 512) {
                const int kq = (int)(e >> 9), n0 = (int)(e & 511) * 8;
                float v[8];
#pragma unroll
                for (int j = 0; j < 8; ++j) { const int n = n0 + j; const int mm = (kq * (n & 2047)) & 2047; const float a = (float)mm * (1.0f / 1024.0f); v[j] = n < 2048 ? cospif(a) : -sinpif(a); }
                u32x4 w; w.x = pk2(v[0], v[1]); w.y = pk2(v[2], v[3]); w.z = pk2(v[4], v[5]); w.w = pk2(v[6], v[7]);
                *(u32x4*)(D2 + (size_t)kq * 4096 + n0) = w;
            }
            bf16_t* D2C = (bf16_t*)(ws + WS_D2C);
            for (int e = bid * 512 + tid; e < 256 * 64; e += G * 512) {
                const int kq = e >> 6, n0 = (e & 63) * 8;
                float v[8];
#pragma unroll
                for (int j = 0; j < 8; ++j) { const int n = n0 + j; const int mm = (kq * (n & 255)) & 255; const float a = (float)mm * (1.0f / 128.0f); v[j] = n < 256 ? cospif(a) : -sinpif(a); }
                u32x4 w; w.x = pk2(v[0], v[1]); w.y = pk2(v[2], v[3]); w.z = pk2(v[4], v[5]); w.w = pk2(v[6], v[7]);
                *(u32x4*)(D2C + (size_t)kq * 512 + n0) = w;
            }
        }
        __syncthreads();
        {
            float* wt = (float*)lds;
            float* tab = (float*)(lds + 64 * 129 * 4);
            bf16_t* W0VF = (bf16_t*)(ws + WS_W0VF);
            for (int it = bid; it < 128; it += G) {
                const int kb = it >> 2, gq = it & 3;
                __syncthreads();
                if (tid < 128) tab[tid] = cospif((float)tid * (1.0f / 64.0f));
                for (int e = tid; e < 64 * 128; e += 512) { const int kk = e >> 7, c = e & 127; wt[kk * 129 + c] = even_w_in[(size_t)(kb * 64 + kk) * 5120 + 4608 + gq * 128 + c]; }
                __syncthreads();
                const int kk = tid & 63, mg = tid >> 6;
                for (int mi = 0; mi < 16; ++mi) {
                    const int mm = mg * 16 + mi;
                    float sa = 0.f, sb = 0.f;
#pragma unroll 8
                    for (int c = 0; c < 128; ++c) { const float wv = wt[kk * 129 + c]; const int ph = (c * mm) & 127; sa += wv * tab[ph]; sb += wv * tab[(ph + 96) & 127]; }
                    W0VF[(size_t)(1536 + gq * 128 + mm) * DM + kb * 64 + kk] = (bf16_t)f2bf(sa);
                    W0VF[(size_t)(2048 + gq * 128 + mm) * DM + kb * 64 + kk] = (bf16_t)f2bf(sb);
                }
            }
        }
        __syncthreads();
        {
            float* scr = (float*)(lds + wave * 16384);
            int base = 0;
#define RUNJOB(W_, ldw_, K_, ncols_, col0_, WT_, mode_, drow_) do { const TJob jb{W_, ldw_, K_, ncols_, col0_, WT_, mode_}; const int ni = tjob_items(jb); \
                const int first = ((gw - base) % NGW + NGW) % NGW; for (int it = first; it < ni; it += NGW) tjob_run(jb, drow_, it, scr, lane); base += ni; } while (0)
            RUNJOB(even_w_in, 5120, DM, 3072, 0, (bf16_t*)(ws + WS_W0QK), 0, 0);
            RUNJOB(even_w_in, 5120, DM, 1536, 3072, (bf16_t*)(ws + WS_W0VF), 0, 0);
            RUNJOB(even_w_out, DM, DM, DM, 0, (bf16_t*)(ws + WS_W0OUT), 0, 0);
            RUNJOB(hgrn_w_in, 10240, DM, 6144, 0, (bf16_t*)(ws + WS_W1A), 0, 0);
            RUNJOB(hgrn_w_in, 10240, DM, DM, 6144, (bf16_t*)(ws + WS_W1V), 0, 0);
            RUNJOB(hgrn_w_in, 10240, DM, DM, 8192, (bf16_t*)(ws + WS_W1A), 0, 6144);
            RUNJOB(hgrn_w_out, DM, DM, DM, 0, (bf16_t*)(ws + WS_W1OUT), 0, 0);
            RUNJOB(ffn_w_up, 2 * DFF, DM, 2 * DFF, 0, (bf16_t*)(ws + WS_WUP), 1, 0);
            RUNJOB(ffn_w_up + (size_t)DM * 2 * DFF, 2 * DFF, DM, 2 * DFF, 0, (bf16_t*)(ws + WS_WUP + 43 * MiB), 1, 0);
            RUNJOB(ffn_w_down, DM, DFF, DM, 0, (bf16_t*)(ws + WS_WDN), 0, 0);
            RUNJOB(ffn_w_down + (size_t)DFF * DM, DM, DFF, DM, 0, (bf16_t*)(ws + WS_WDN + 21 * MiB + 512 * 1024), 0, 0);
#undef RUNJOB
        }
    }
    grid.sync();

    for (int r = gw; r < MTOT; r += NGW) {
        const bool lat = r < MLAT;
        const float* zr = lat ? x + (size_t)r * DM : ctx + (size_t)(r - MLAT) * DM;
        const float* mrow = modv + (size_t)(0 * 9 + (lat ? (r >> 11) : 8)) * NMOD;
        row_op(zr, nullptr, nullptr, nullptr, false, mrow + 0 * DM, mrow + 1 * DM, U + (size_t)r * DM, lane);
    }
    GRID_BAR();

    {
        pg8::Gemm g1{U, (const bf16_t*)(ws + WS_W0QK), MTOT, 3072, DM}; pg8::StaticOrder S1; S1.init(MTOT, 3072, G, bid);
        EpiQK E1{(bf16_t*)(ws + R_QK), rope};
        pg8::gemm_phase<EpiQK, pg8::StaticOrder, GEMM_ALIGN, GEMM_SP2>(ldsg, g1, S1, E1);
        pg8::Gemm g2{(const bf16_t*)(ws + WS_W0VF), U, 2560, MTOT, DM}; pg8::StaticOrder S2; S2.init(2560, MTOT, G, (bid + 128) % G);
        EpiT E2{(bf16_t*)(ws + R_VT0), (bf16_t*)(ws + R_FTL), (bf16_t*)(ws + R_FTC), 0};
        pg8::gemm_phase<EpiT, pg8::StaticOrder, GEMM_ALIGN, GEMM_SP2>(ldsg, g2, S2, E2);
    }
    GRID_BAR();

    {
        pg8::Gemm gf{(const bf16_t*)(ws + WS_D2), (const bf16_t*)(ws + R_FTL), 2048, 4096, 4096}; pg8::StaticOrder Sf; Sf.init(2048, 4096, G, bid);
        EpiFour Ef{(bf16_t*)(ws + R_CAT), 0, SEQ, 1.0f / 512.0f};
        pg8::gemm_phase<EpiFour, pg8::StaticOrder, GEMM_ALIGN, GEMM_SP2>(ldsg, gf, Sf, Ef);
        pg8::Gemm gc{(const bf16_t*)(ws + WS_D2C), (const bf16_t*)(ws + R_FTC), 256, 4096, 512}; pg8::StaticOrder Sc; Sc.init(256, 4096, G, (bid + G - 128) % G);
        EpiFour Ec{(bf16_t*)(ws + R_CAT), MLAT, CTXL, 0.005524271728019903f};
        pg8::gemm_phase<EpiFour, pg8::StaticOrder, GEMM_ALIGN, GEMM_SP2>(ldsg, gc, Sc, Ec);
        float lam;
        {
            const float d01 = wave_sum(diff_lambda[lane] * diff_lambda[64 + lane]);
            const float d23 = wave_sum(diff_lambda[128 + lane] * diff_lambda[192 + lane]);
            lam = expf(d01) - expf(d23) + LAM_INIT0;
        }
        volatile int* qslot = (volatile int*)(lds + LDS_MISC);
        const int xq0 = (int)(xbar.x & 7u);
        for (int dq = 0; dq < 8; ++dq) {
        const int xq = (xq0 + dq) & 7;
        for (;;) {
            __syncthreads();
            if (tid == 0) *qslot = (int)atomicAdd(ctl + 64 + 64 * xq, 1u);
            __syncthreads();
            const int idx = *qslot;
            if (idx >= 216) break;
            int unit;
            if (idx < 192) unit = (xq * 12 + (idx >> 4)) * 16 + (idx & 15);
            else unit = 1536 + (xq * 12 + ((idx - 192) >> 1)) * 2 + ((idx - 192) & 1);
            attn_unit(lds, (const bf16_t*)(ws + R_QK), (const bf16_t*)(ws + R_VT0), (bf16_t*)(ws + R_CAT), diff_subln, lam, unit);
        }
        }
    }
    GRID_BAR();

    {
        pg8::Gemm g{(const bf16_t*)(ws + R_CAT), (const bf16_t*)(ws + WS_W0OUT), MTOT, DM, DM}; pg8::StaticOrder S; S.init(MTOT, DM, G, bid);
        EpiResid E{(bf16_t*)(ws + R_MB), modv + 0 * 9 * NMOD + 2 * DM};
        pg8::gemm_phase<EpiResid, pg8::StaticOrder, GEMM_ALIGN, GEMM_SP2>(ldsg, g, S, E);
    }
    GRID_BAR();

#define HROW(r) ((r) < MLAT ? hlat + (size_t)(r) * DM : hctx + (size_t)((r) - MLAT) * DM)
    { f32x4 gpre[8], bpre[8];
#pragma unroll
    for (int j = 0; j < 8; ++j) { gpre[j] = *((const f32x4*)ln_mix_g + lane + 64 * j); bpre[j] = *((const f32x4*)ln_mix_b + lane + 64 * j); }
    for (int r = gw; r < MTOT; r += NGW) {
        const float* mrow = modv + (size_t)(0 * 9 + (r < MLAT ? (r >> 11) : 8)) * NMOD;
        row_op(r < MLAT ? x + (size_t)r * DM : ctx + (size_t)(r - MLAT) * DM, HROW(r), ln_mix_g, ln_mix_b, true, mrow + 3 * DM, mrow + 4 * DM, U + (size_t)r * DM, lane, (const bf16_t*)(ws + R_MB) + (size_t)r * DM, gpre, bpre);
    }
    }
    GRID_BAR();

#define FFN_PHASES(L, MROWS) \
    { \
        pg8::Gemm g{U, (const bf16_t*)(ws + WS_WUP + (size_t)(L) * 43 * MiB), (MROWS), 2 * DFF, DM}; pg8::StaticOrder S; S.init((MROWS), 2 * DFF, G, bid); \
        EpiUpFused E{(bf16_t*)(ws + R_A1), (float*)(ws + R_EDGE), (float*)(ws + R_EDGE + 4 * MiB), (float*)(ws + R_EDGE + 8 * MiB), ffn_conv_w + (size_t)(L) * 3 * DFF, ffn_conv_b + (size_t)(L) * DFF, (float*)(lds + LDS_MISC + 1024)}; \
        pg8::gemm_phase<EpiUpFused, pg8::StaticOrder, true, GEMM_SP2>(ldsg, g, S, E); \
    } \
    GRID_BAR(); \
    { \
        bf16_t* HID = (bf16_t*)(ws + R_A1); const float* EA = (const float*)(ws + R_EDGE); const float* EP = (const float*)(ws + R_EDGE + 4 * MiB); const float* EV = (const float*)(ws + R_EDGE + 8 * MiB); \
        const float* cw = ffn_conv_w + (size_t)(L) * 3 * DFF; \
        const int nedge = ((MROWS) / 256) * 2 * DFF; \
        for (int it = bid * 512 + tid; it < nedge; it += G * 512) { \
            const int c = it % DFF, pe = it / DFF, pm = pe >> 1, e = pe & 1; \
            const bool lat = pm < 64; \
            float nb = 0.f; \
            if (e == 0) { if (lat && (pm & 7) != 0) nb = EA[(size_t)((pm - 1) * 2 + 1) * DFF + c]; } \
            else { if (lat && (pm & 7) != 7) nb = EA[(size_t)((pm + 1) * 2 + 0) * DFF + c]; } \
            const float cv = EP[(size_t)pe * DFF + c] + nb * cw[(e ? 2 * DFF : 0) + c]; \
            HID[(size_t)(pm * 256 + (e ? 255 : 0)) * DFF + c] = (bf16_t)f2bf(gelu_f(cv) * EV[(size_t)pe * DFF + c]); \
        } \
    } \
    GRID_BAR(); \
    { \
        pg8::Gemm g{(const bf16_t*)(ws + R_A1), (const bf16_t*)(ws + WS_WDN + (size_t)(L) * (21 * MiB + 512 * 1024)), (MROWS), DM, DFF}; pg8::StaticOrder S; S.init((MROWS), DM, G, bid); \
        EpiResid E{(bf16_t*)(ws + R_MB), modv + (size_t)(L) * 9 * NMOD + 5 * DM}; \
        pg8::gemm_phase<EpiResid, pg8::StaticOrder, GEMM_ALIGN, GEMM_SP2>(ldsg, g, S, E); \
    } \
    GRID_BAR();

    FFN_PHASES(0, MTOT)

    { f32x4 gpre[8], bpre[8];
#pragma unroll
    for (int j = 0; j < 8; ++j) { gpre[j] = *((const f32x4*)ln_ffn_g + lane + 64 * j); bpre[j] = *((const f32x4*)ln_ffn_b + lane + 64 * j); }
    for (int r = gw; r < MTOT; r += NGW) {
        const float* mrow = modv + (size_t)(1 * 9 + (r < MLAT ? (r >> 11) : 8)) * NMOD;
        row_op(HROW(r), HROW(r), ln_ffn_g, ln_ffn_b, true, mrow + 0 * DM, mrow + 1 * DM, U + (size_t)r * DM, lane, (const bf16_t*)(ws + R_MB) + (size_t)r * DM, gpre, bpre);
    }
    }
    GRID_BAR();

    {
        pg8::Gemm g1{U, (const bf16_t*)(ws + WS_W1A), MLAT, 8192, DM}; pg8::StaticOrder S1; S1.init(MLAT, 8192, G, bid);
        EpiH1 E1{(bf16_t*)(ws + R_Q1), (_Float16*)(ws + R_LF), (bf16_t*)(ws + R_G1), hgrn_lb, 0, 0};
        pg8::gemm_phase<EpiH1, pg8::StaticOrder, GEMM_ALIGN, GEMM_SP2>(ldsg, g1, S1, E1);
        pg8::Gemm g1c{U + (size_t)MLAT * DM, (const bf16_t*)(ws + WS_W1A) + (size_t)2048 * DM, MCTX, 4096, DM}; pg8::StaticOrder S1c; S1c.init(MCTX, 4096, G, bid);
        EpiH1 E1c{(bf16_t*)(ws + R_Q1), (_Float16*)(ws + R_LF), (bf16_t*)(ws + R_G1), hgrn_lb, MLAT, 8};
        pg8::gemm_phase<EpiH1, pg8::StaticOrder, GEMM_ALIGN, GEMM_SP2>(ldsg, g1c, S1c, E1c);
        pg8::Gemm g2{(const bf16_t*)(ws + WS_W1V), U, 2048, MTOT, DM}; pg8::StaticOrder S2; S2.init(2048, MTOT, G, (bid + 128) % G);
        EpiT E2{(bf16_t*)(ws + R_VT1), nullptr, nullptr, 1};
        pg8::gemm_phase<EpiT, pg8::StaticOrder, GEMM_ALIGN, GEMM_SP2>(ldsg, g2, S2, E2);
    }
    GRID_BAR();

    for (int rep = 0; rep < (PROBE == 2 ? 2 : 1); ++rep)
    for (int chain = bid; chain < 256; chain += G) {
        const int dir = chain & 1, bh = chain >> 1, b = bh >> 4, h = bh & 15;
        __syncthreads();
        scan_chain(lds, (const bf16_t*)(ws + R_Q1), (const _Float16*)(ws + R_LF) + (size_t)dir * MTOT * DM, (const bf16_t*)(ws + R_VT1),
                   dir ? (bf16_t*)(ws + R_OB) : U, b, h, dir);
    }
    GRID_BAR();

    {
        const bf16_t* OF = U; const bf16_t* OB = (const bf16_t*)(ws + R_OB); const bf16_t* G1 = (const bf16_t*)(ws + R_G1); bf16_t* Y = (bf16_t*)(ws + R_Q1);
        float nw[32];
#pragma unroll
        for (int q8 = 0; q8 < 8; ++q8) { const f32x4 t4 = *(const f32x4*)(hgrn_norm + (lane & 3) * 32 + q8 * 4); nw[q8 * 4 + 0] = t4[0]; nw[q8 * 4 + 1] = t4[1]; nw[q8 * 4 + 2] = t4[2]; nw[q8 * 4 + 3] = t4[3]; }
        for (int r = gw; r < MLAT; r += NGW) {
            const size_t off = (size_t)r * DM + lane * 32;
            float o[32]; float ss = 0.f;
            u32x4 ggv[4];
#pragma unroll
            for (int q4 = 0; q4 < 4; ++q4) ggv[q4] = *(const u32x4*)(G1 + off + q4 * 8);
#pragma unroll
            for (int q4 = 0; q4 < 4; ++q4) {
                const u32x4 a = *(const u32x4*)(OF + off + q4 * 8), bq = *(const u32x4*)(OB + off + q4 * 8);
#pragma unroll
                for (int e = 0; e < 4; ++e) {
                    const float lo = bf2f((unsigned short)(a[e] & 0xffffu)) + bf2f((unsigned short)(bq[e] & 0xffffu));
                    const float hi = bf2f((unsigned short)(a[e] >> 16)) + bf2f((unsigned short)(bq[e] >> 16));
                    o[q4 * 8 + 2 * e] = lo; o[q4 * 8 + 2 * e + 1] = hi; ss += lo * lo + hi * hi;
                }
            }
            ss += __shfl_xor(ss, 1); ss += __shfl_xor(ss, 2);
            const float rs = 1.0f / sqrtf(ss * (1.0f / 128.0f) + RMS_EPS_F);
            const int d0 = (lane & 3) * 32;
#pragma unroll
            for (int q4 = 0; q4 < 4; ++q4) {
                const u32x4 gg = ggv[q4];
                u32x4 ow;
#pragma unroll
                for (int e = 0; e < 4; ++e) {
                    const float lo = o[q4 * 8 + 2 * e] * rs * nw[q4 * 8 + 2 * e] * bf2f((unsigned short)(gg[e] & 0xffffu));
                    const float hi = o[q4 * 8 + 2 * e + 1] * rs * nw[q4 * 8 + 2 * e + 1] * bf2f((unsigned short)(gg[e] >> 16));
                    ow[e] = pk2(lo, hi);
                }
                *(u32x4*)(Y + off + q4 * 8) = ow;
            }
        }
    }
    GRID_BAR();

    {
        pg8::Gemm g{(const bf16_t*)(ws + R_Q1), (const bf16_t*)(ws + WS_W1OUT), MLAT, DM, DM}; pg8::StaticOrder S; S.init(MLAT, DM, G, bid);
        EpiResid E{(bf16_t*)(ws + R_MB), modv + (size_t)1 * 9 * NMOD + 2 * DM};
        pg8::gemm_phase<EpiResid, pg8::StaticOrder, GEMM_ALIGN, GEMM_SP2>(ldsg, g, S, E);
    }
    GRID_BAR();

    { f32x4 gpre[8], bpre[8];
#pragma unroll
    for (int j = 0; j < 8; ++j) { gpre[j] = *((const f32x4*)(ln_mix_g + DM) + lane + 64 * j); bpre[j] = *((const f32x4*)(ln_mix_b + DM) + lane + 64 * j); }
    for (int r = gw; r < MLAT; r += NGW) {
        const float* mrow = modv + (size_t)(1 * 9 + (r >> 11)) * NMOD;
        row_op(HROW(r), HROW(r), ln_mix_g + DM, ln_mix_b + DM, true, mrow + 3 * DM, mrow + 4 * DM, U + (size_t)r * DM, lane, (const bf16_t*)(ws + R_MB) + (size_t)r * DM, gpre, bpre);
    }
    }
    GRID_BAR();

    FFN_PHASES(1, MLAT)

    f32x4 gpre[8], bpre[8];
#pragma unroll
    for (int j = 0; j < 8; ++j) { gpre[j] = *((const f32x4*)(ln_ffn_g + DM) + lane + 64 * j); bpre[j] = *((const f32x4*)(ln_ffn_b + DM) + lane + 64 * j); }
    for (int r = gw; r < MLAT; r += NGW)
        row_op(HROW(r), HROW(r), ln_ffn_g + DM, ln_ffn_b + DM, true, nullptr, nullptr, nullptr, lane, (const bf16_t*)(ws + R_MB) + (size_t)r * DM, gpre, bpre);
}

extern "C" void kernel_launch(void* const* d_in, const int* in_sizes, int n_in, void* d_out, int out_size, void* d_ws, size_t ws_size, hipStream_t stream) {
    static int grid = 0;
    if (grid == 0) {
        if (n_in != 22 || ws_size < WS_END) { fprintf(stderr, "kernel_launch: unexpected n_in %d / ws_size %zu\n", n_in, ws_size); grid = -1; return; }
        int dev = 0, cus = 0, per_cu = 0;
        (void)hipGetDevice(&dev);
        (void)hipDeviceGetAttribute(&cus, hipDeviceAttributeMultiprocessorCount, dev);
        if (hipFuncSetAttribute((const void*)hybrid_fwd, hipFuncAttributeMaxDynamicSharedMemorySize, LDS_BYTES) != hipSuccess) { fprintf(stderr, "kernel_launch: hipFuncSetAttribute failed\n"); grid = -1; return; }
        if (hipOccupancyMaxActiveBlocksPerMultiprocessor(&per_cu, (const void*)hybrid_fwd, 512, LDS_BYTES) != hipSuccess || per_cu < 1) { fprintf(stderr, "kernel_launch: occupancy query gives %d\n", per_cu); per_cu = 1; }
        (void)hipGetLastError();
        grid = cus * 1;
    }
    if (grid < 0) return;
    (void)hipMemsetAsync((char*)d_ws + WS_CTL, 0, 65536, stream);
    Args a{};
    for (int i = 0; i < 22; ++i) a.in[i] = (const float*)d_in[i];
    a.out = (float*)d_out; a.ws = (unsigned char*)d_ws; a.dbg = 0; a.pad = 0;
    void* kargs[] = {&a};
    hipError_t e = hipLaunchCooperativeKernel((const void*)hybrid_fwd, dim3(grid), dim3(512), kargs, LDS_BYTES, stream);
    if (e != hipSuccess) fprintf(stderr, "kernel_launch: cooperative launch failed: %s (grid %d)\n", hipGetErrorString(e), grid);
}
```
